# Optimizing an MI355X kernel written in HIP

```python
import jax, jax.numpy as jnp
from jax import lax
import numpy as np

D_MODEL = 1024
BATCH = 8
SEQ = 2048
DEPTH = 2

MEM_LEN = 256
SB_HEADS = 8
SB_HEAD_DIM = 64
SB_WIDTH = SB_HEADS * SB_HEAD_DIM
SB_BLOCK = 128
ML_HEADS = 4
ML_HEAD_DIM = 128
ML_WIDTH = ML_HEADS * ML_HEAD_DIM
ML_CHUNK = 64
CONV_WIDTH = 4
MIX_WIDTH = SB_WIDTH + ML_WIDTH
N_IN = 3 * SB_WIDTH + 4 * ML_WIDTH + 2 * ML_HEADS
X_HEADS = 4
X_HEAD_DIM = D_MODEL // X_HEADS
D_FF = 2816
EPS = 1e-6

kernel_name = "hybrid_sb_mlstm_macaron_block"


def rms_norm(x, g):
    xf = x.astype(jnp.float32)
    y = xf * lax.rsqrt(jnp.mean(xf * xf, axis=-1, keepdims=True) + EPS)
    return (y * g.astype(jnp.float32)).astype(x.dtype)


def swiglu(x, w_gate, w_up, w_down):
    return (jax.nn.silu(x @ w_gate) * (x @ w_up)) @ w_down


def split_heads(a, n_heads, head_dim):
    b, s, _ = a.shape
    return a.reshape(b, s, n_heads, head_dim).transpose(0, 2, 1, 3)


def merge_heads(a):
    b, h, s, d = a.shape
    return a.transpose(0, 2, 1, 3).reshape(b, s, h * d)


def causal_depthwise_conv(u, w, b):
    k_width = w.shape[0]
    s = u.shape[1]
    up = jnp.pad(u, ((0, 0), (k_width - 1, 0), (0, 0)))
    y = b
    for j in range(k_width):
        y = y + up[:, j:j + s] * w[j]
    return y


def stick_breaking_attention(q, k, v):
    _, _, s_len, d = q.shape
    scale = d ** -0.5
    outs = []
    for blk in range(s_len // SB_BLOCK):
        q0 = blk * SB_BLOCK
        end = q0 + SB_BLOCK
        qb = q[:, :, q0:end].astype(jnp.float32)
        kb = k[:, :, :end].astype(jnp.float32)
        z = jnp.einsum('bhtd,bhsd->bhts', qb, kb) * scale
        t_idx = q0 + jnp.arange(SB_BLOCK)[:, None]
        s_idx = jnp.arange(end)[None, :]
        strict = s_idx < t_idx
        log_not = jnp.where(strict, jax.nn.log_sigmoid(-z), 0.0)
        later = lax.cumsum(log_not, axis=3, reverse=True) - log_not
        a = jnp.where(strict, jnp.exp(jax.nn.log_sigmoid(z) + later), 0.0)
        outs.append(jnp.einsum('bhts,bhsd->bhtd', a, v[:, :, :end].astype(jnp.float32)))
    return jnp.concatenate(outs, axis=2).astype(v.dtype)


def mlstm_chunkwise(q, k, v, i_pre, f_pre):
    b_sz, h_sz, s_len, d = q.shape
    n_chunks = s_len // ML_CHUNK
    qf = q.astype(jnp.float32) * (d ** -0.5)
    kf = k.astype(jnp.float32)
    vf = v.astype(jnp.float32)
    log_i = i_pre.astype(jnp.float32)
    log_f = jax.nn.log_sigmoid(f_pre.astype(jnp.float32))

    def to_chunks(a):
        return jnp.moveaxis(a.reshape(b_sz, h_sz, n_chunks, ML_CHUNK, *a.shape[3:]), 2, 0)

    causal = jnp.tril(jnp.ones((ML_CHUNK, ML_CHUNK), dtype=bool))

    def step(carry, xs):
        c_st, n_st, m_st = carry
        qc, kc, vc, li, lf = xs
        bcum = jnp.cumsum(lf, axis=-1)
        dmat = jnp.where(causal, bcum[..., :, None] - bcum[..., None, :] + li[..., None, :], -jnp.inf)
        inter = bcum + m_st[..., None]
        m_t = jnp.maximum(jnp.max(dmat, axis=-1), inter)
        w_intra = jnp.exp(dmat - m_t[..., None])
        w_inter = jnp.exp(inter - m_t)
        sc = jnp.einsum('bhtd,bhsd->bhts', qc, kc) * w_intra
        num = jnp.einsum('bhts,bhsd->bhtd', sc, vc) + w_inter[..., None] * jnp.einsum('bhtd,bhde->bhte', qc, c_st)
        den = jnp.sum(sc, axis=-1) + w_inter * jnp.einsum('bhtd,bhd->bht', qc, n_st)
        h = num / jnp.maximum(jnp.abs(den), jnp.exp(-m_t))[..., None]
        m_new = m_t[..., -1]
        w_state = jnp.exp(bcum[..., -1:] - bcum + li - m_new[..., None])
        decay = jnp.exp(bcum[..., -1] + m_st - m_new)
        c_new = decay[..., None, None] * c_st + jnp.einsum('bhs,bhsd,bhse->bhde', w_state, kc, vc)
        n_new = decay[..., None] * n_st + jnp.einsum('bhs,bhsd->bhd', w_state, kc)
        return (c_new, n_new, m_new), h

    init = (jnp.zeros((b_sz, h_sz, d, d), jnp.float32),
            jnp.zeros((b_sz, h_sz, d), jnp.float32),
            jnp.zeros((b_sz, h_sz), jnp.float32))
    xs = (to_chunks(qf), to_chunks(kf), to_chunks(vf), to_chunks(log_i), to_chunks(log_f))
    _, hs = lax.scan(step, init, xs)
    return jnp.moveaxis(hs, 0, 2).reshape(b_sz, h_sz, s_len, d).astype(q.dtype)


def memory_cross_attention(u, mem_n, w_xq, w_xk, w_xv, g_qnorm, g_knorm, w_xo):
    q = rms_norm(split_heads(u @ w_xq, X_HEADS, X_HEAD_DIM), g_qnorm)
    k = rms_norm(split_heads(mem_n @ w_xk, X_HEADS, X_HEAD_DIM), g_knorm)
    v = split_heads(mem_n @ w_xv, X_HEADS, X_HEAD_DIM)
    s = jnp.einsum('bhtd,bhmd->bhtm', q.astype(jnp.float32), k.astype(jnp.float32)) * (X_HEAD_DIM ** -0.5)
    p = jax.nn.softmax(s, axis=-1)
    o = jnp.einsum('bhtm,bhmd->bhtd', p, v.astype(jnp.float32)).astype(u.dtype)
    return merge_heads(o) @ w_xo


def hybrid_layer(x, mem, g_ff1, w_ff1_gate, w_ff1_up, w_ff1_down, g_mix, w_in, b_gate,
                 w_conv, b_conv, g_mlstm_head, w_out, g_xattn, g_mem, w_xq, w_xk, w_xv,
                 g_qnorm, g_knorm, w_xo, g_ff2, w_ff2_gate, w_ff2_up, w_ff2_down):
    x = x + 0.5 * swiglu(rms_norm(x, g_ff1), w_ff1_gate, w_ff1_up, w_ff1_down)

    u = rms_norm(x, g_mix)
    proj = u @ w_in
    sizes = (SB_WIDTH,) * 3 + (ML_WIDTH,) * 4 + (ML_HEADS, ML_HEADS)
    sb_q, sb_k, sb_v, ml_q, ml_k, ml_v, ml_o, ml_i, ml_f = jnp.split(
        proj, np.cumsum(sizes)[:-1].tolist(), axis=-1)

    sb = stick_breaking_attention(split_heads(sb_q, SB_HEADS, SB_HEAD_DIM),
                                  split_heads(sb_k, SB_HEADS, SB_HEAD_DIM),
                                  split_heads(sb_v, SB_HEADS, SB_HEAD_DIM))
    sb = merge_heads(sb)

    qk = jax.nn.silu(causal_depthwise_conv(jnp.concatenate([ml_q, ml_k], axis=-1), w_conv, b_conv))
    ml_qc, ml_kc = jnp.split(qk, 2, axis=-1)
    i_pre = (ml_i + b_gate[:ML_HEADS]).transpose(0, 2, 1)
    f_pre = (ml_f + b_gate[ML_HEADS:]).transpose(0, 2, 1)
    hm = mlstm_chunkwise(split_heads(ml_qc, ML_HEADS, ML_HEAD_DIM),
                         split_heads(ml_kc, ML_HEADS, ML_HEAD_DIM),
                         split_heads(ml_v, ML_HEADS, ML_HEAD_DIM), i_pre, f_pre)
    hm = rms_norm(hm, g_mlstm_head[:, None, :])
    ml = merge_heads(hm) * jax.nn.sigmoid(ml_o)

    x = x + jnp.concatenate([sb, ml], axis=-1) @ w_out

    x = x + memory_cross_attention(rms_norm(x, g_xattn), rms_norm(mem, g_mem),
                                   w_xq, w_xk, w_xv, g_qnorm, g_knorm, w_xo)

    x = x + 0.5 * swiglu(rms_norm(x, g_ff2), w_ff2_gate, w_ff2_up, w_ff2_down)
    return x


def setup_inputs(seed: int = 0) -> dict:
    key = jax.random.key(seed)
    ks = jax.random.split(key, 32)
    f32 = jnp.float32

    def w(k, shape, fan_in):
        return jax.random.normal(k, shape, f32) * (fan_in ** -0.5)

    def gain(k, shape):
        return 1.0 + 0.02 * jax.random.normal(k, shape, f32)

    L = DEPTH
    i_bias = 0.1 * jax.random.normal(ks[8], (L, ML_HEADS), f32)
    f_bias = 3.0 + 0.5 * jax.random.normal(ks[9], (L, ML_HEADS), f32)
    return {
        "x": jax.random.normal(ks[0], (BATCH, SEQ, D_MODEL), f32),
        "mem": jax.random.normal(ks[1], (BATCH, MEM_LEN, D_MODEL), f32),
        "g_ff1": gain(ks[2], (L, D_MODEL)),
        "w_ff1_gate": w(ks[3], (L, D_MODEL, D_FF), D_MODEL),
        "w_ff1_up": w(ks[4], (L, D_MODEL, D_FF), D_MODEL),
        "w_ff1_down": w(ks[5], (L, D_FF, D_MODEL), D_FF),
        "g_mix": gain(ks[6], (L, D_MODEL)),
        "w_in": w(ks[7], (L, D_MODEL, N_IN), D_MODEL),
        "b_gate": jnp.concatenate([i_bias, f_bias], axis=-1),
        "w_conv": w(ks[10], (L, CONV_WIDTH, 2 * ML_WIDTH), CONV_WIDTH),
        "b_conv": 0.02 * jax.random.normal(ks[11], (L, 2 * ML_WIDTH), f32),
        "g_mlstm_head": gain(ks[12], (L, ML_HEADS, ML_HEAD_DIM)),
        "w_out": w(ks[13], (L, MIX_WIDTH, D_MODEL), MIX_WIDTH),
        "g_xattn": gain(ks[14], (L, D_MODEL)),
        "g_mem": gain(ks[15], (L, D_MODEL)),
        "w_xq": w(ks[16], (L, D_MODEL, D_MODEL), D_MODEL),
        "w_xk": w(ks[17], (L, D_MODEL, D_MODEL), D_MODEL),
        "w_xv": w(ks[18], (L, D_MODEL, D_MODEL), D_MODEL),
        "g_qnorm": gain(ks[19], (L, X_HEAD_DIM)),
        "g_knorm": gain(ks[20], (L, X_HEAD_DIM)),
        "w_xo": w(ks[21], (L, D_MODEL, D_MODEL), D_MODEL),
        "g_ff2": gain(ks[22], (L, D_MODEL)),
        "w_ff2_gate": w(ks[23], (L, D_MODEL, D_FF), D_MODEL),
        "w_ff2_up": w(ks[24], (L, D_MODEL, D_FF), D_MODEL),
        "w_ff2_down": w(ks[25], (L, D_FF, D_MODEL), D_FF),
    }


def reference(x, mem, g_ff1, w_ff1_gate, w_ff1_up, w_ff1_down, g_mix, w_in, b_gate,
              w_conv, b_conv, g_mlstm_head, w_out, g_xattn, g_mem, w_xq, w_xk, w_xv,
              g_qnorm, g_knorm, w_xo, g_ff2, w_ff2_gate, w_ff2_up, w_ff2_down):
    for l in range(DEPTH):
        x = hybrid_layer(x, mem, g_ff1[l], w_ff1_gate[l], w_ff1_up[l], w_ff1_down[l],
                         g_mix[l], w_in[l], b_gate[l], w_conv[l], b_conv[l],
                         g_mlstm_head[l], w_out[l], g_xattn[l], g_mem[l], w_xq[l],
                         w_xk[l], w_xv[l], g_qnorm[l], g_knorm[l], w_xo[l], g_ff2[l],
                         w_ff2_gate[l], w_ff2_up[l], w_ff2_down[l])
    return x
```

```cpp
#include <hip/hip_runtime.h>
#include <hip/hip_cooperative_groups.h>
#include <cstdio>
#include <cstdint>
namespace cg = cooperative_groups;

#ifndef MK_ONE
#define MK_ONE 1
#endif

#ifndef PH_MASK
#define PH_MASK 0x1ff
#endif
#define PH_ON(k) (((PH_MASK) >> (k)) & 1)
#define LAS __attribute__((address_space(3)))
typedef unsigned short bf16_t;
typedef short bf16x8 __attribute__((ext_vector_type(8)));
typedef float f32x4 __attribute__((ext_vector_type(4)));
typedef unsigned u32x4 __attribute__((ext_vector_type(4)));
typedef unsigned u32x2 __attribute__((ext_vector_type(2)));

constexpr int BATCH = 8, SEQ = 2048, D = 1024, M = BATCH * SEQ, FF = 2816, NGU = 2 * FF, NIN = 3592, NINP = 3584, MEML = 256, MM = BATCH * MEML;
constexpr float EPS = 1e-6f;
constexpr int NPH = 26;

constexpr size_t MiB = 1u << 20;
constexpr size_t WS_CTL = 0;
constexpr size_t WS_SS = 64 * 1024;
constexpr size_t WS_SSM = WS_SS + 2 * MiB;
constexpr size_t WS_GI = WS_SSM + 128 * 1024;
constexpr size_t WS_GF = WS_GI + 256 * 1024;
constexpr size_t WS_WG = WS_GF + 256 * 1024;
constexpr size_t WS_MLS = WS_WG + 64 * 1024;
constexpr size_t WS_WGB = WS_MLS + 16 * 1024;
constexpr size_t WS_W = 3 * MiB;
constexpr size_t W_GU1 = WS_W, W_D1 = W_GU1 + 11 * MiB, W_IN = W_D1 + 5 * MiB + 512 * 1024, W_OUT = W_IN + 7 * MiB, W_XQ = W_OUT + 2 * MiB, W_XO = W_XQ + 2 * MiB,
                 W_GU2 = W_XO + 2 * MiB, W_D2 = W_GU2 + 11 * MiB, W_END = W_D2 + 5 * MiB + 512 * 1024;
constexpr size_t WS_WKV = 49 * MiB;
constexpr size_t WS_XB = 57 * MiB;
constexpr size_t WS_BIG = 89 * MiB;
constexpr size_t WS_MIXO = 201 * MiB;
constexpr size_t WS_KV = 233 * MiB;
constexpr size_t WS_MEMB = 249 * MiB;
constexpr size_t WS_END = 254 * MiB;
static_assert(W_END == 49 * MiB, "weight map");

constexpr int RING_BYTES = 131072;
constexpr int XSCR_OFF = RING_BYTES;
constexpr int MISC_OFF = XSCR_OFF + 4096;
constexpr int RT_OFF = 139264;
constexpr int LDS_BYTES = 147456;

typedef float f32x2_t __attribute__((ext_vector_type(2)));
typedef __bf16 bf16x2_t __attribute__((ext_vector_type(2)));
__device__ __forceinline__ unsigned pk(float lo, float hi) { f32x2_t v = {lo, hi}; bf16x2_t b = __builtin_convertvector(v, bf16x2_t); return __builtin_bit_cast(unsigned, b); }
__device__ __forceinline__ float bflo(unsigned u) { return __uint_as_float(u << 16); }
__device__ __forceinline__ float bfhi(unsigned u) { return __uint_as_float(u & 0xffff0000u); }
__device__ __forceinline__ float fexp(float x) { return __builtin_amdgcn_exp2f(x * 1.4426950408889634f); }
__device__ __forceinline__ float flog(float x) { return __builtin_amdgcn_logf(x) * 0.6931471805599453f; }
__device__ __forceinline__ float frcp(float x) { return __builtin_amdgcn_rcpf(x); }
__device__ __forceinline__ float softplus(float z) { return fmaxf(z, 0.f) + flog(1.f + fexp(-fabsf(z))); }
__device__ __forceinline__ float sigmoidf_(float z) { return frcp(1.f + fexp(-z)); }
__device__ __forceinline__ float wave_sum(float v) {
#pragma unroll
    for (int o = 1; o < 64; o <<= 1) v += __shfl_xor(v, o);
    return v;
}
__device__ __forceinline__ f32x4 mfma16(bf16x8 a, bf16x8 b, f32x4 c) { return __builtin_amdgcn_mfma_f32_16x16x32_bf16(a, b, c, 0, 0, 0); }
__device__ __forceinline__ bf16x8 mk8(u32x2 a, u32x2 b) { u32x4 t; t.x = a.x; t.y = a.y; t.z = b.x; t.w = b.y; return __builtin_bit_cast(bf16x8, t); }
__device__ __forceinline__ bf16x8 mk8u(unsigned a, unsigned b, unsigned c, unsigned d) { u32x4 t; t.x = a; t.y = b; t.z = c; t.w = d; return __builtin_bit_cast(bf16x8, t); }
typedef short v4i16_t __attribute__((ext_vector_type(4)));
__device__ __forceinline__ u32x2 trd(const LAS bf16_t* p) { return __builtin_bit_cast(u32x2, __builtin_amdgcn_ds_read_tr16_b64_v4i16((LAS v4i16_t*)p)); }
__device__ __forceinline__ float rowscale(const float* ss, int row) {
    const f32x4 a = *(const f32x4*)(ss + (size_t)row * 4);
    return __builtin_amdgcn_rsqf(((a.x + a.y) + (a.z + a.w)) * (1.f / 1024.f) + EPS);
}
#define LDS_WAIT() asm volatile("s_waitcnt lgkmcnt(0)" ::: "memory")
#define WG_BAR() do { asm volatile("s_waitcnt vmcnt(0) lgkmcnt(0)" ::: "memory"); __builtin_amdgcn_s_barrier(); asm volatile("" ::: "memory"); } while (0)
#define LBAR() do { asm volatile("s_waitcnt lgkmcnt(0)" ::: "memory"); __builtin_amdgcn_s_barrier(); asm volatile("" ::: "memory"); } while (0)

namespace pg8 {
constexpr int BM = 256, BK = 64, HALF = 128, HTB = HALF * BK * 2, STAGE_BYTES = 8 * HTB, NXCD = 8, WGM = 8;
__host__ __device__ __forceinline__ int lds_byte(int r, int c) { const int st = (r >> 4) * 2 + (c >> 5), rr = r & 15, cc = c & 31, ob = rr * 64 + cc * 2; return st * 1024 + (ob ^ (((ob >> 9) & 1) << 5)); }
__host__ __device__ __forceinline__ void stage_rc(int b, int& R, int& C) { const int st = b / 1024, sb = b % 1024, swz = sb ^ (((sb >> 9) & 1) << 5); R = (st >> 1) * 16 + swz / 64; C = (st & 1) * 32 + (swz % 64) / 2; }
__host__ __device__ __forceinline__ int perm32(int rho) { const int n = rho >> 4, i = rho & 15; return 8 * (i >> 2) + 4 * n + (i & 3); }
struct Unit { int pm, pn; };
struct Gemm { const bf16_t* A; const bf16_t* Bt; int M, N, K; };
struct StaticOrder {
    int nM, nN, nwg, G, c;
    __host__ __device__ void init(int M_, int N_, int G_, int c_) { nM = M_ / BM; nN = N_ / BM; nwg = nM * nN; G = G_; c = c_; }
    __host__ __device__ bool next(int i, Unit& u) const {
        const long L = (long)i * G + c; if (L >= nwg) return false;
        int wgid = (int)L; { const int q = nwg / NXCD, r = nwg % NXCD, xcd = wgid % NXCD, off = wgid / NXCD; wgid = (xcd < r ? xcd * (q + 1) : r * (q + 1) + (xcd - r) * q) + off; }
        const int nig = WGM * nN, gid = wgid / nig, fm = gid * WGM, gsz = (nM - fm) < WGM ? (nM - fm) : WGM;
        u.pm = fm + ((wgid % nig) % gsz); u.pn = (wgid % nig) / gsz; return true;
    }
};
typedef f32x4 Acc[2][2][4][2];

struct RowTab { const LAS float* rt; int base_pm; };
__device__ __forceinline__ float rs_get(const RowTab& T, const float* ss, const Unit& u, int rl) {
    return T.rt[((u.pm - T.base_pm) & 7) * BM + rl];
}
struct EpiSwiglu {
    static constexpr bool USE_RT = true, AFTER_DRAIN = false;
    bf16_t* H; const float* ss;
    __device__ __forceinline__ void operator()(const Acc& acc, const Unit& u, int wr, int wc, int fr, int fq, const RowTab& T) const {
        const int row0 = u.pm * BM + wr * 64 + fr, col0 = u.pn * HALF + wc * 32 + 8 * fq;
#pragma unroll
        for (int ai = 0; ai < 2; ++ai)
#pragma unroll
            for (int m = 0; m < 4; ++m) {
                const int row = row0 + ai * HALF + m * 16; const float r = rs_get(T, ss, u, ai * HALF + wr * 64 + m * 16 + fr);
                const float rs_ = r * -1.4426950408889634f, r2 = r * r;
                float hv[8];
#pragma unroll
                for (int n = 0; n < 2; ++n)
#pragma unroll
                    for (int e = 0; e < 4; ++e) { const float g = acc[ai][0][m][n][e], up = acc[ai][1][m][n][e]; hv[4 * n + e] = (g * up) * (r2 * frcp(1.f + __builtin_amdgcn_exp2f(g * rs_))); }
                u32x4 w; w.x = pk(hv[0], hv[1]); w.y = pk(hv[2], hv[3]); w.z = pk(hv[4], hv[5]); w.w = pk(hv[6], hv[7]);
                *(u32x4*)(H + (size_t)row * FF + col0) = w;
            }
    }
};
template <bool IN_F32, bool OUT_F32>
struct EpiResid {
    static constexpr bool USE_RT = false, AFTER_DRAIN = false; static constexpr const float* ss = nullptr;
    const float* xin; float* xout; bf16_t* xb; float* ssout; float alpha; LAS float* P;
    __device__ __forceinline__ void operator()(const Acc& acc, const Unit& u, int wr, int wc, int fr, int fq, const RowTab& T) const {
        const int row0 = u.pm * BM + wr * 64 + fr, col0 = u.pn * BM + wc * 32 + 8 * fq;
#pragma unroll
        for (int ai = 0; ai < 2; ++ai) {
            u32x4 xh[4][2];
            if (!IN_F32) {
#pragma unroll
                for (int m = 0; m < 4; ++m)
#pragma unroll
                    for (int bj = 0; bj < 2; ++bj) xh[m][bj] = *(const u32x4*)(xb + (size_t)(row0 + ai * HALF + m * 16) * D + col0 + bj * HALF);
            }
            f32x4 xv[4][2][2];
            if (IN_F32) {
#pragma unroll
                for (int m = 0; m < 4; ++m)
#pragma unroll
                    for (int bj = 0; bj < 2; ++bj) { const size_t off = (size_t)(row0 + ai * HALF + m * 16) * D + col0 + bj * HALF; xv[m][bj][0] = *(const f32x4*)(xin + off); xv[m][bj][1] = *(const f32x4*)(xin + off + 4); }
            }
#pragma unroll
            for (int m = 0; m < 4; ++m) {
                const int row = row0 + ai * HALF + m * 16; float sq = 0.f;
#pragma unroll
                for (int bj = 0; bj < 2; ++bj) {
                    const size_t off = (size_t)row * D + col0 + bj * HALF;
                    f32x4 x0, x1;
                    if (IN_F32) { x0 = xv[m][bj][0]; x1 = xv[m][bj][1]; }
                    else { const u32x4 h = xh[m][bj]; x0 = (f32x4){bflo(h.x), bfhi(h.x), bflo(h.y), bfhi(h.y)}; x1 = (f32x4){bflo(h.z), bfhi(h.z), bflo(h.w), bfhi(h.w)}; }
                    const f32x4 a = x0 + acc[ai][bj][m][0] * alpha, b = x1 + acc[ai][bj][m][1] * alpha;
                    if (OUT_F32) { *(f32x4*)(xout + off) = a; *(f32x4*)(xout + off + 4) = b; }
                    sq += (a.x * a.x + a.y * a.y) + (a.z * a.z + a.w * a.w) + (b.x * b.x + b.y * b.y) + (b.z * b.z + b.w * b.w);
                    if (!OUT_F32) { u32x4 w; w.x = pk(a.x, a.y); w.y = pk(a.z, a.w); w.z = pk(b.x, b.y); w.w = pk(b.z, b.w); *(u32x4*)(xb + off) = w; }
                }
                if (!OUT_F32) { sq += __shfl_xor(sq, 16); sq += __shfl_xor(sq, 32);
                    if (fq == 0) P[(ai * HALF + wr * 64 + m * 16 + fr) * 4 + wc] = sq; }
            }
            asm volatile("" ::: "memory");
        }
        LBAR();
        if (!OUT_F32 && threadIdx.x < 256) { const f32x4 p = *(const LAS f32x4*)(P + threadIdx.x * 4); ssout[(size_t)(u.pm * BM + threadIdx.x) * 4 + u.pn] = (p.x + p.y) + (p.z + p.w); }
    }
};
struct EpiProj {
    static constexpr bool USE_RT = true, AFTER_DRAIN = false;
    bf16_t* O; int ldc; const float* ss;
    __device__ __forceinline__ void operator()(const Acc& acc, const Unit& u, int wr, int wc, int fr, int fq, const RowTab& T) const {
        const int row0 = u.pm * BM + wr * 64 + fr, col0 = u.pn * BM + wc * 32 + 8 * fq;
#pragma unroll
        for (int ai = 0; ai < 2; ++ai)
#pragma unroll
            for (int m = 0; m < 4; ++m) {
                const int row = row0 + ai * HALF + m * 16; const float r = rs_get(T, ss, u, ai * HALF + wr * 64 + m * 16 + fr);
#pragma unroll
                for (int bj = 0; bj < 2; ++bj) {
                    const f32x4 a = acc[ai][bj][m][0] * r, b = acc[ai][bj][m][1] * r;
                    u32x4 w; w.x = pk(a.x, a.y); w.y = pk(a.z, a.w); w.z = pk(b.x, b.y); w.w = pk(b.z, b.w);
                    *(u32x4*)(O + (size_t)row * ldc + col0 + bj * HALF) = w;
                }
            }
    }
};
struct EpiHeadNorm {
    static constexpr bool USE_RT = true, AFTER_DRAIN = false;
    bf16_t* O; int ldc; const float* ss; const float* gain0; const float* gain1; LAS float* P;
    __device__ __forceinline__ void operator()(const Acc& acc, const Unit& u, int wr, int wc, int fr, int fq, const RowTab& T) const {
        const int row0 = u.pm * BM + wr * 64 + fr, col0 = u.pn * BM + wc * 32 + 8 * fq;
        const bool normed = ((u.pn >> 2) & 1) == 0; const float* gain = (u.pn >= 8) ? gain1 : gain0;
        float rs[2][4];
#pragma unroll
        for (int ai = 0; ai < 2; ++ai)
#pragma unroll
            for (int m = 0; m < 4; ++m) {
                const float r = rs_get(T, ss, u, ai * HALF + wr * 64 + m * 16 + fr); rs[ai][m] = r; float sq = 0.f;
#pragma unroll
                for (int bj = 0; bj < 2; ++bj)
#pragma unroll
                    for (int n = 0; n < 2; ++n) { const f32x4 v = acc[ai][bj][m][n] * r; sq += (v.x * v.x + v.y * v.y) + (v.z * v.z + v.w * v.w); }
                sq += __shfl_xor(sq, 16); sq += __shfl_xor(sq, 32);
                if (fq == 0) P[(ai * HALF + wr * 64 + m * 16 + fr) * 4 + wc] = sq;
            }
        LBAR();
        f32x4 g[2][2];
#pragma unroll
        for (int bj = 0; bj < 2; ++bj)
#pragma unroll
            for (int n = 0; n < 2; ++n) g[bj][n] = normed ? *(const f32x4*)(gain + bj * HALF + wc * 32 + 8 * fq + 4 * n) : (f32x4){1.f, 1.f, 1.f, 1.f};
#pragma unroll
        for (int ai = 0; ai < 2; ++ai)
#pragma unroll
            for (int m = 0; m < 4; ++m) {
                const int rl = ai * HALF + wr * 64 + m * 16 + fr; const f32x4 p = *(const LAS f32x4*)(P + rl * 4);
                const float tot = (p.x + p.y) + (p.z + p.w); const float rn = rs[ai][m] * (normed ? __builtin_amdgcn_rsqf(tot * (1.f / 256.f) + EPS) : 1.f);
                const int row = row0 + ai * HALF + m * 16;
#pragma unroll
                for (int bj = 0; bj < 2; ++bj) {
                    const f32x4 a = acc[ai][bj][m][0] * rn * g[bj][0], b = acc[ai][bj][m][1] * rn * g[bj][1];
                    u32x4 w; w.x = pk(a.x, a.y); w.y = pk(a.z, a.w); w.z = pk(b.x, b.y); w.w = pk(b.z, b.w);
                    *(u32x4*)(O + (size_t)row * ldc + col0 + bj * HALF) = w;
                }
            }
    }
};

template <class Epi>
__device__ __forceinline__ void gemm_phase(LAS unsigned char* lds, const Gemm g, const StaticOrder& S, const Epi& E) {
    int tid = threadIdx.x; asm volatile("" : "+v"(tid));
    const int wid = __builtin_amdgcn_readfirstlane(tid >> 6), lane = tid & 63, wr = wid >> 2, wc = wid & 3, fr = lane & 15, fq = lane >> 4;
    const int K = g.K, nt = K / BK;
    unsigned voffA[2], voffB[2];
#pragma unroll
    for (int i = 0; i < 2; ++i) { int R, C; stage_rc(tid * 16 + i * 8192, R, C); const int Rb = (R & ~31) + perm32(R & 31);
        voffA[i] = (unsigned)(R * K + C) * 2u; voffB[i] = (unsigned)(Rb * K + C) * 2u; }
    const size_t kstep = (size_t)(BK * 2);
    const size_t hstep = (size_t)HALF * K * 2;
    const size_t tstep = 2 * hstep;
    const unsigned ldsw = (unsigned)wid * 1024u;
    const int aoff = lds_byte(wr * 64 + fr, fq * 8), boff = lds_byte(wc * 32 + fr, fq * 8);
#define PG8_SA(b, h) (((b) * 2 + (h)) * HTB)
#define PG8_SB(b, h) ((4 + (b) * 2 + (h)) * HTB)
#define PG8_STAGE(bufoff, gbase, voff) do { _Pragma("unroll") for (int _i = 0; _i < 2; ++_i) \
        __builtin_amdgcn_global_load_lds((const unsigned*)((const char*)(gbase) + (voff)[_i]), (LAS unsigned*)(lds + (bufoff) + ldsw + _i * 8192), 16, 0, 0); } while (0)
#define PG8_LDA(dst, b, h) do { _Pragma("unroll") for (int m = 0; m < 4; ++m) _Pragma("unroll") for (int k = 0; k < 2; ++k) dst[m][k] = *(const LAS bf16x8*)(lds + PG8_SA(b, h) + aoff + m * 2048 + k * 1024); } while (0)
#define PG8_LDB(dst, b, h) do { _Pragma("unroll") for (int n = 0; n < 2; ++n) _Pragma("unroll") for (int k = 0; k < 2; ++k) dst[n][k] = *(const LAS bf16x8*)(lds + PG8_SB(b, h) + boff + n * 2048 + k * 1024); } while (0)
#define PG8_MMA(ai, bj, At, Bt) do { __builtin_amdgcn_s_setprio(1); _Pragma("unroll") for (int m = 0; m < 4; ++m) _Pragma("unroll") for (int n = 0; n < 2; ++n) _Pragma("unroll") for (int k = 0; k < 2; ++k) \
        acc[ai][bj][m][n] = __builtin_amdgcn_mfma_f32_16x16x32_bf16(Bt[n][k], At[m][k], acc[ai][bj][m][n], 0, 0, 0); __builtin_amdgcn_s_setprio(0); } while (0)
#define PG8_WAIT_V(n) asm volatile("s_waitcnt vmcnt(" #n ")" ::: "memory")
#define PG8_WAIT_L(n) asm volatile("s_waitcnt lgkmcnt(" #n ")" ::: "memory")
#define PG8_BAR __builtin_amdgcn_s_barrier()
#define PG8_SCHED __builtin_amdgcn_sched_barrier(0)
    Unit cur, nxt; int ui = 0;
    if (!S.next(0, cur)) return;
    RowTab T; T.rt = (const LAS float*)(lds + RT_OFF); T.base_pm = (cur.pm >> 3) << 3;
    f32x4 rtv[4];
    if constexpr (Epi::USE_RT) {
#pragma unroll
        for (int j = 0; j < 4; ++j) { const int row = T.base_pm * BM + tid + 512 * j; rtv[j] = (row < g.M) ? *(const f32x4*)(E.ss + (size_t)row * 4) : (f32x4){1.f, 1.f, 1.f, 1.f}; }
    }
    Acc acc;
#pragma unroll
    for (int a = 0; a < 2; ++a)
#pragma unroll
        for (int b = 0; b < 2; ++b)
#pragma unroll
            for (int m = 0; m < 4; ++m)
#pragma unroll
                for (int n = 0; n < 2; ++n) acc[a][b][m][n] = (f32x4){0.f, 0.f, 0.f, 0.f};
    bf16x8 At[4][2], B0[2][2], B1[2][2];
    const char* cA = (const char*)g.A + (size_t)cur.pm * tstep; const char* cB = (const char*)g.Bt + (size_t)cur.pn * tstep;
    PG8_STAGE(PG8_SB(0, 0), cB, voffB); PG8_STAGE(PG8_SB(0, 1), cB + hstep, voffB); PG8_STAGE(PG8_SA(0, 0), cA, voffA); PG8_STAGE(PG8_SA(0, 1), cA + hstep, voffA);
    if constexpr (Epi::USE_RT) {
        LAS float* rtw = (LAS float*)(lds + RT_OFF);
#pragma unroll
        for (int j = 0; j < 4; ++j) rtw[tid + 512 * j] = __builtin_amdgcn_rsqf(((rtv[j].x + rtv[j].y) + (rtv[j].z + rtv[j].w)) * (1.f / 1024.f) + EPS);
        asm volatile("s_waitcnt lgkmcnt(0)" ::: "memory");
    }
    if (wr == 1) PG8_BAR;
    PG8_WAIT_V(2); PG8_BAR;
    PG8_STAGE(PG8_SB(1, 0), cB + kstep, voffB); PG8_STAGE(PG8_SA(1, 0), cA + kstep, voffA); PG8_STAGE(PG8_SB(1, 1), cB + hstep + kstep, voffB);
    PG8_WAIT_V(6); PG8_BAR;
    for (;;) {
        const bool has_next = S.next(ui + 1, nxt);
        const char* nA = has_next ? (const char*)g.A + (size_t)nxt.pm * tstep : cA; const char* nB = has_next ? (const char*)g.Bt + (size_t)nxt.pn * tstep : cB;
        for (int t = 0; t < nt; t += 2) {
            const bool last = (t == nt - 2);
            const char* a1 = cA + (size_t)(t + 1) * kstep;
            const char* a2 = last ? nA : cA + (size_t)(t + 2) * kstep; const char* b2 = last ? nB : cB + (size_t)(t + 2) * kstep;
            const char* a3 = a2 + kstep; const char* b3 = b2 + kstep;
            PG8_LDB(B0, 0, 0); PG8_LDB(B1, 0, 1); PG8_SCHED; PG8_LDA(At, 0, 0); PG8_STAGE(PG8_SA(1, 1), a1 + hstep, voffA);
            PG8_WAIT_V(8); PG8_WAIT_L(0); PG8_BAR; PG8_MMA(0, 0, At, B0); PG8_MMA(0, 1, At, B1); PG8_BAR; PG8_SCHED;
            PG8_LDA(At, 0, 1); PG8_STAGE(PG8_SB(0, 0), b2, voffB); PG8_STAGE(PG8_SB(0, 1), b2 + hstep, voffB); PG8_STAGE(PG8_SA(0, 0), a2, voffA);
            PG8_WAIT_V(8); PG8_WAIT_L(0); PG8_BAR; PG8_MMA(1, 0, At, B0); PG8_MMA(1, 1, At, B1); PG8_BAR; PG8_SCHED;
            PG8_LDB(B0, 1, 0); PG8_LDB(B1, 1, 1); PG8_SCHED; PG8_LDA(At, 1, 0); PG8_STAGE(PG8_SA(0, 1), a2 + hstep, voffA);
            PG8_WAIT_V(8); PG8_WAIT_L(0); PG8_BAR; PG8_MMA(0, 0, At, B0); PG8_MMA(0, 1, At, B1); PG8_BAR; PG8_SCHED;
            PG8_LDA(At, 1, 1); PG8_STAGE(PG8_SB(1, 0), b3, voffB); PG8_STAGE(PG8_SB(1, 1), b3 + hstep, voffB); PG8_STAGE(PG8_SA(1, 0), a3, voffA);
            PG8_WAIT_V(8); PG8_WAIT_L(0); PG8_BAR; PG8_MMA(1, 0, At, B0); PG8_MMA(1, 1, At, B1); PG8_BAR; PG8_SCHED;
        }
        if (wr == 0) PG8_BAR;
        if constexpr (!Epi::AFTER_DRAIN) E(acc, cur, wr, wc, fr, fq, T);
        if (!has_next) break;
#pragma unroll
        for (int a = 0; a < 2; ++a)
#pragma unroll
            for (int b = 0; b < 2; ++b)
#pragma unroll
                for (int m = 0; m < 4; ++m)
#pragma unroll
                    for (int n = 0; n < 2; ++n) acc[a][b][m][n] = (f32x4){0.f, 0.f, 0.f, 0.f};
        cur = nxt; cA = nA; cB = nB; ++ui;
        if (wr == 1) PG8_BAR;
    }
    PG8_WAIT_V(0);
    PG8_BAR;
    if constexpr (Epi::AFTER_DRAIN) E(acc, cur, wr, wc, fr, fq, T);
#undef PG8_SA
#undef PG8_SB
#undef PG8_STAGE
#undef PG8_LDA
#undef PG8_LDB
#undef PG8_MMA
#undef PG8_WAIT_V
#undef PG8_WAIT_L
#undef PG8_BAR
#undef PG8_SCHED
}
}

struct Args { const float* in[25]; float* out; unsigned char* ws; int ph_lo, ph_hi; };

struct Ctx {
    LAS unsigned char* lds; int tid, lane, wave, G, blk;
};

__device__ __forceinline__ void tr_item(const float* W, int ldw, const float* g, int K, bf16_t* dst, int k0, int n0, int drow0, LAS float* scr, int lane) {
    { f32x4 v[8]; const int c4 = (lane & 7) * 4;
#pragma unroll
      for (int i = 0; i < 8; ++i) { const int kk = (lane >> 3) + 8 * i; v[i] = *(const f32x4*)(W + (size_t)(k0 + kk) * ldw + n0 + c4); }
#pragma unroll
      for (int i = 0; i < 8; ++i) { const int kk = (lane >> 3) + 8 * i; f32x4 t = v[i]; if (g) t = t * g[k0 + kk];
          LAS float* d = scr + kk * 33 + c4; d[0] = t.x; d[1] = t.y; d[2] = t.z; d[3] = t.w; } }
    LDS_WAIT(); asm volatile("" ::: "memory");
    const int c = lane & 7;
#pragma unroll
    for (int j = 0; j < 4; ++j) { const int n = (lane >> 3) + 8 * j; const LAS float* s = scr + (8 * c) * 33 + n;
        u32x4 o; o.x = pk(s[0 * 33], s[1 * 33]); o.y = pk(s[2 * 33], s[3 * 33]); o.z = pk(s[4 * 33], s[5 * 33]); o.w = pk(s[6 * 33], s[7 * 33]);
        *(u32x4*)(dst + (size_t)(drow0 + n) * K + k0 + 8 * c) = o; }
    LDS_WAIT(); asm volatile("" ::: "memory");
}
__device__ __forceinline__ void tr_plain(const float* W, int ldw, const float* g, int K, int N, bf16_t* dst, int drow_off, int item, LAS float* scr, int lane) {
    const int nnb = N / 32, kb = item / nnb, nb = item % nnb; tr_item(W, ldw, g, K, dst, kb * 64, nb * 32, drow_off + nb * 32, scr, lane);
}
__device__ __forceinline__ void tr_gu(const float* W, const float* g, bf16_t* dst, int upoff, int item, LAS float* scr, int lane) {
    const int nnb = FF / 32, kb = item / nnb, nb = item % nnb, n0 = nb * 32; tr_item(W, FF, g, D, dst, kb * 64, n0, (n0 >> 7) * 256 + (n0 & 127) + upoff, scr, lane);
}
__device__ __forceinline__ void conv_phase(const Ctx& C, const Args& a, int l) {
    LAS float* scr = (LAS float*)(C.lds + C.wave * 16384);
    unsigned char* ws = a.ws;
    const int gw = C.blk * 8 + C.wave, NGW = C.G * 8, lane = C.lane;
    constexpr int I_GU = 16 * 88, I_DN = 44 * 32, I_IN = 16 * 112, I_SQ = 16 * 32;
    const int n_layer = 6 * I_GU + I_IN + 3 * I_SQ;
    const int n_items = n_layer + (l == 0 ? 4 * I_SQ : 0);
    for (int it = gw; it < n_items; it += NGW) {
        int r = it;
        if (r < I_GU) { tr_gu(a.in[3] + (size_t)l * D * FF, a.in[2] + l * D, (bf16_t*)(ws + W_GU1), 0, r, scr, lane); continue; } r -= I_GU;
        if (r < I_GU) { tr_gu(a.in[4] + (size_t)l * D * FF, a.in[2] + l * D, (bf16_t*)(ws + W_GU1), 128, r, scr, lane); continue; } r -= I_GU;
        if (r < I_DN) { tr_plain(a.in[5] + (size_t)l * FF * D, D, nullptr, FF, D, (bf16_t*)(ws + W_D1), 0, r, scr, lane); continue; } r -= I_DN;
        if (r < I_GU) { tr_gu(a.in[22] + (size_t)l * D * FF, a.in[21] + l * D, (bf16_t*)(ws + W_GU2), 0, r, scr, lane); continue; } r -= I_GU;
        if (r < I_GU) { tr_gu(a.in[23] + (size_t)l * D * FF, a.in[21] + l * D, (bf16_t*)(ws + W_GU2), 128, r, scr, lane); continue; } r -= I_GU;
        if (r < I_DN) { tr_plain(a.in[24] + (size_t)l * FF * D, D, nullptr, FF, D, (bf16_t*)(ws + W_D2), 0, r, scr, lane); continue; } r -= I_DN;
        if (r < I_IN) { tr_plain(a.in[7] + (size_t)l * D * NIN, NIN, a.in[6] + l * D, D, NINP, (bf16_t*)(ws + W_IN), 0, r, scr, lane); continue; } r -= I_IN;
        if (r < I_SQ) { tr_plain(a.in[12] + (size_t)l * D * D, D, nullptr, D, D, (bf16_t*)(ws + W_OUT), 0, r, scr, lane); continue; } r -= I_SQ;
        if (r < I_SQ) { tr_plain(a.in[15] + (size_t)l * D * D, D, a.in[13] + l * D, D, D, (bf16_t*)(ws + W_XQ), 0, r, scr, lane); continue; } r -= I_SQ;
        if (r < I_SQ) { tr_plain(a.in[20] + (size_t)l * D * D, D, nullptr, D, D, (bf16_t*)(ws + W_XO), 0, r, scr, lane); continue; } r -= I_SQ;
        { const int which = r / I_SQ, rr = r % I_SQ, ll = which >> 1, kv = which & 1;
          tr_plain(a.in[kv ? 17 : 16] + (size_t)ll * D * D, D, a.in[14] + ll * D, D, D, (bf16_t*)(ws + WS_WKV), ll * 2048 + kv * 1024, rr, scr, lane); }
    }
    if (l == 0) {
        float* ss0 = (float*)(ws + WS_SS); float* ssm = (float*)(ws + WS_SSM);
        for (int m0 = gw; m0 < M + MM; m0 += 2 * NGW) {
            f32x4 v[2][4]; float sq[2];
#pragma unroll
            for (int u = 0; u < 2; ++u) { const int m = m0 + u * NGW; if (m < M + MM) { const bool isx = m < M; const int row = isx ? m : m - M;
                const f32x4* xr = (const f32x4*)((isx ? a.in[0] : a.in[1]) + (size_t)row * D) + lane;
#pragma unroll
                for (int j = 0; j < 4; ++j) v[u][j] = xr[64 * j]; } }
#pragma unroll
            for (int u = 0; u < 2; ++u) { const int m = m0 + u * NGW; if (m < M + MM) { const bool isx = m < M; const int row = isx ? m : m - M;
                bf16_t* dst = (bf16_t*)(ws + (isx ? WS_XB : WS_MEMB)) + (size_t)row * D; float s = 0.f;
#pragma unroll
                for (int j = 0; j < 4; ++j) s += (v[u][j].x * v[u][j].x + v[u][j].y * v[u][j].y) + (v[u][j].z * v[u][j].z + v[u][j].w * v[u][j].w);
                s = wave_sum(s); sq[u] = s;
#pragma unroll
                for (int j = 0; j < 4; ++j) { u32x2 w; w.x = pk(v[u][j].x, v[u][j].y); w.y = pk(v[u][j].z, v[u][j].w); *((u32x2*)dst + lane + 64 * j) = w; }
                if (lane < 4) (isx ? ss0 : ssm)[(size_t)row * 4 + lane] = (lane == 0) ? sq[u] : 0.f; } }
        }
        bf16_t* wgb = (bf16_t*)(ws + WS_WGB);
        for (int idx = C.blk * 512 + C.tid; idx < 2 * 16 * 512; idx += C.G * 512) {
            const int ll = idx >> 13, j = (idx >> 9) & 15, k = (idx & 511) * 2;
            float w0 = 0.f, w1 = 0.f;
            if (j < 8) { w0 = a.in[6][ll * D + k] * a.in[7][(size_t)ll * D * NIN + (size_t)k * NIN + NINP + j]; w1 = a.in[6][ll * D + k + 1] * a.in[7][(size_t)ll * D * NIN + (size_t)(k + 1) * NIN + NINP + j]; }
            ((unsigned*)wgb)[idx] = pk(w0, w1);
        }
        if (C.blk == 0 && C.tid < 64) ((unsigned*)(ws + WS_CTL))[C.tid * 64] = 0u;
    }
}

__device__ __forceinline__ void gates_pass(const Ctx& C, const Args& a, int l, const float* ss) {
    const int hb = C.G / 2;
    if (C.blk < hb) return;
    unsigned char* ws = a.ws;
    const bf16_t* xbp = (const bf16_t*)(ws + WS_XB); const bf16_t* wgb = (const bf16_t*)(ws + WS_WGB) + (size_t)l * 16 * 1024;
    float* gi = (float*)(ws + WS_GI); float* gf = (float*)(ws + WS_GF);
    const float* bg = a.in[8] + l * 8;
    const int lane = C.lane, fr = lane & 15, fq = lane >> 4;
    const int gw = (C.blk - hb) * 8 + C.wave, NGW = (C.G - hb) * 8;
    for (int task = gw; task < M / 16; task += NGW) {
        const int row0 = task * 16;
        const bf16_t* ap = xbp + (size_t)(row0 + fr) * D + 8 * fq; const bf16_t* bp = wgb + fr * 1024 + 8 * fq;
        f32x4 acc = (f32x4){0.f, 0.f, 0.f, 0.f};
#pragma unroll 8
        for (int kk = 0; kk < 32; ++kk) acc = mfma16(*(const bf16x8*)(ap + 32 * kk), *(const bf16x8*)(bp + 32 * kk), acc);
        if (fr < 8) {
            const int r0 = row0 + 4 * fq, b = r0 >> 11, s = r0 & 2047, h = fr & 3; const float bias = bg[fr];
            f32x4 o;
#pragma unroll
            for (int e = 0; e < 4; ++e) { const float pre = acc[e] * rowscale(ss, r0 + e) + bias; o[e] = (fr < 4) ? pre : fminf(pre, 0.f) - flog(1.f + fexp(-fabsf(pre))); }
            *(f32x4*)((fr < 4 ? gi : gf) + (size_t)(b * 4 + h) * SEQ + s) = o;
        }
    }
}

constexpr int SB_KS = 72;
constexpr int SB_BUF = 2 * 64 * SB_KS * 2;
template <bool MASKED>
__device__ __forceinline__ void sb_tile(const LAS bf16_t* Ks, const LAS bf16_t* Vs, int k0, int tq, int fr, int fq, const bf16x8 (&qf)[2],
                                        const bf16x8 UA, const bf16x8 UB, const bf16x8 ONES, f32x4 (&oacc)[4], float& carry) {
    f32x4 z[4];
#pragma unroll
    for (int i = 0; i < 4; ++i) {
        z[i] = (f32x4){0.f, 0.f, 0.f, 0.f};
#pragma unroll
        for (int kk = 0; kk < 2; ++kk) { const bf16x8 kf = *(const LAS bf16x8*)(Ks + (16 * i + fr) * SB_KS + 32 * kk + 8 * fq); z[i] = mfma16(kf, qf[kk], z[i]); }
    }
    float Lv[4][4], zl[4][4];
    const int lim = tq - k0 - 4 * fq;
#pragma unroll
    for (int i = 0; i < 4; ++i)
#pragma unroll
        for (int e = 0; e < 4; ++e) {
            float zz = z[i][e] * 0.18033688011112042f;
            if (MASKED) zz = (16 * i + e < lim) ? zz : -1e30f;
            const float sp = fmaxf(zz, 0.f) + __builtin_amdgcn_logf(1.f + __builtin_amdgcn_exp2f(-fabsf(zz)));
            Lv[i][e] = -sp; zl[i][e] = zz - sp;
        }
    bf16x8 hi[2];
#pragma unroll
    for (int kk = 0; kk < 2; ++kk) hi[kk] = mk8u(pk(Lv[2 * kk][0], Lv[2 * kk][1]), pk(Lv[2 * kk][2], Lv[2 * kk][3]), pk(Lv[2 * kk + 1][0], Lv[2 * kk + 1][1]), pk(Lv[2 * kk + 1][2], Lv[2 * kk + 1][3]));
    f32x4 tot = (f32x4){0.f, 0.f, 0.f, 0.f};
#pragma unroll
    for (int kk = 0; kk < 2; ++kk) tot = mfma16(ONES, hi[kk], tot);
    unsigned pw[2][4];
#pragma unroll
    for (int io = 0; io < 4; ++io) {
        f32x4 lt = (f32x4){carry, carry, carry, carry};
        { const bf16x8 ud = (io & 1) ? UB : UA; lt = mfma16(ud, hi[io >> 1], lt); }
        if (io < 2) lt = mfma16(ONES, hi[1], lt);
        float av[4];
#pragma unroll
        for (int e = 0; e < 4; ++e) av[e] = __builtin_amdgcn_exp2f(zl[io][e] + lt[e]);
        pw[io >> 1][(io & 1) * 2 + 0] = pk(av[0], av[1]); pw[io >> 1][(io & 1) * 2 + 1] = pk(av[2], av[3]);
    }
    const bf16x8 P0 = mk8u(pw[0][0], pw[0][1], pw[0][2], pw[0][3]), P1 = mk8u(pw[1][0], pw[1][1], pw[1][2], pw[1][3]);
#pragma unroll
    for (int dt = 0; dt < 4; ++dt) {
        const LAS bf16_t* vr = Vs + (4 * fq + (fr >> 2)) * SB_KS + 16 * dt + 4 * (fr & 3);
        const bf16x8 v0 = mk8(trd(vr), trd(vr + 16 * SB_KS)), v1 = mk8(trd(vr + 32 * SB_KS), trd(vr + 48 * SB_KS));
        oacc[dt] = mfma16(v0, P0, oacc[dt]); oacc[dt] = mfma16(v1, P1, oacc[dt]);
    }
    carry += tot[0];
}
__device__ __forceinline__ void sb_unit(const Ctx& C, const bf16_t* proj, bf16_t* mixo, int b, int h, int qb) {
    const int tid = C.tid, lane = C.lane, wid = C.wave, fr = lane & 15, fq = lane >> 4;
    const int q0 = qb * 128, tq = q0 + wid * 16 + fr;
    const size_t rowbase = (size_t)b * SEQ;
    bf16x8 qf[2];
    { const bf16_t* qp = proj + (rowbase + tq) * NINP + h * 64 + 8 * fq; qf[0] = *(const bf16x8*)qp; qf[1] = *(const bf16x8*)(qp + 32); }
    unsigned dg0, dg1;
    { const int d = fr - 4 * fq; dg0 = (0 > d ? 0x3F80u : 0u) | (1 > d ? 0x3F800000u : 0u); dg1 = (2 > d ? 0x3F80u : 0u) | (3 > d ? 0x3F800000u : 0u); }
    const bf16x8 UA = mk8u(dg0, dg1, 0x3F803F80u, 0x3F803F80u), UB = mk8u(0u, 0u, dg0, dg1);
    const bf16x8 ONES = mk8u(0x3F803F80u, 0x3F803F80u, 0x3F803F80u, 0x3F803F80u);
    f32x4 oacc[4];
#pragma unroll
    for (int i = 0; i < 4; ++i) oacc[i] = (f32x4){0.f, 0.f, 0.f, 0.f};
    float carry = 0.f;
    const int jt_max = 2 * qb + 1;
    const int ss_ = tid >> 3, sc_ = tid & 7;
    const bf16_t* kvp = proj + (rowbase + ss_) * NINP + h * 64 + 8 * sc_;
    u32x4 kreg, vreg;
    { const bf16_t* p = kvp + (size_t)(jt_max * 64) * NINP; kreg = *(const u32x4*)(p + 512); vreg = *(const u32x4*)(p + 1024); }
    int cur = 0;
    volatile LAS int* dflag = (volatile LAS int*)(C.lds + MISC_OFF) + 16;
    if (lane == 0) { dflag[wid] = 0; dflag[8 + wid] = 0; }
    int par = 0;
    for (int jt = jt_max; jt >= 0; --jt) {
        LAS unsigned char* buf = C.lds + cur * SB_BUF;
        LAS bf16_t* Ks = (LAS bf16_t*)buf; LAS bf16_t* Vs = (LAS bf16_t*)(buf + 64 * SB_KS * 2);
        *(LAS u32x4*)(Ks + ss_ * SB_KS + 8 * sc_) = kreg;
        *(LAS u32x4*)(Vs + ss_ * SB_KS + 8 * sc_) = vreg;
        if (jt > 0) { const bf16_t* p = kvp + (size_t)((jt - 1) * 64) * NINP; kreg = *(const u32x4*)(p + 512); vreg = *(const u32x4*)(p + 1024); }
        LBAR();
        { const int f = dflag[(par ^ 1) * 8 + (lane & 7)];
          if (__builtin_amdgcn_readfirstlane(__builtin_popcountll(__ballot(f != 0))) == 64) break; }
        const int k0 = jt * 64;
        if (k0 < q0 + wid * 16 + 15 && __ballot(carry < -160.f) != ~0ull) {
            if (k0 + 63 >= q0 + wid * 16) sb_tile<true>(Ks, Vs, k0, tq, fr, fq, qf, UA, UB, ONES, oacc, carry);
            else sb_tile<false>(Ks, Vs, k0, tq, fr, fq, qf, UA, UB, ONES, oacc, carry);
        }
        { const bool dead = __ballot(carry < -160.f) == ~0ull; if (lane == 0) dflag[par * 8 + wid] = dead ? 1 : 0; }
        cur ^= 1; par ^= 1;
    }
    bf16_t* op = mixo + (rowbase + tq) * D + h * 64 + 4 * fq;
#pragma unroll
    for (int dt = 0; dt < 4; ++dt) { u32x2 w; w.x = pk(oacc[dt][0], oacc[dt][1]); w.y = pk(oacc[dt][2], oacc[dt][3]); *(u32x2*)(op + 16 * dt) = w; }
    LBAR();
}

constexpr int ML_QS = 136, ML_VS = 152, ML_CTS = 136;
constexpr int ML_Q = 0, ML_K = ML_Q + 64 * ML_QS * 2, ML_V = ML_K + 64 * ML_QS * 2, ML_CT = ML_V + 64 * ML_VS * 2,
              ML_VEC = ML_CT + 144 * ML_CTS * 2, ML_EX = ML_VEC + 8 * 64 * 4, ML_CW = ML_EX + 2 * 64 * 4, ML_END = ML_CW + 10 * 128 * 4;
static_assert(ML_END <= RING_BYTES, "mlstm LDS");
constexpr int ML_SLOT = 144 * 128 * 2;
__device__ __forceinline__ unsigned char* ml_slot(float* dout, int item) { return (unsigned char*)dout + (size_t)item * ML_SLOT; }
template <int MODE>
__device__ __forceinline__ void mlstm_item(const Ctx& C, const Args& a, int l, int item) {
    const int tid = C.tid, lane = C.lane, wid = C.wave, fr = lane & 15, fq = lane >> 4;
    const int b = item >> 7, h = (item >> 5) & 3, c = item & 31;
    unsigned char* ws = a.ws;
    const bf16_t* proj = (const bf16_t*)(ws + WS_BIG); bf16_t* mixo = (bf16_t*)(ws + WS_MIXO);
    const float* gi = (const float*)(ws + WS_GI) + (size_t)(b * 4 + h) * SEQ; const float* gf = (const float*)(ws + WS_GF) + (size_t)(b * 4 + h) * SEQ;
    float* mlA = (float*)(ws + WS_MLS); float* mlG = mlA + 1024; float* mlM = mlA + 2048;
    LAS bf16_t* Qs = (LAS bf16_t*)(C.lds + ML_Q); LAS bf16_t* Ks = (LAS bf16_t*)(C.lds + ML_K); LAS bf16_t* Vs = (LAS bf16_t*)(C.lds + ML_V); LAS bf16_t* Ct = (LAS bf16_t*)(C.lds + ML_CT);
    LAS float* vec = (LAS float*)(C.lds + ML_VEC);
    LAS float* ex = (LAS float*)(C.lds + ML_EX); LAS float* cw = (LAS float*)(C.lds + ML_CW);
    const size_t rowbase = (size_t)b * SEQ;
    const int dch = tid & 15, rg = tid >> 4;
    const int vs = tid >> 3, vc = tid & 7;
    const int tt = wid & 3, half = wid >> 2;
    const float q_scale = 0.08838834764831845f;
    const int s0 = c * 64;
    {
        float cwr[3];
        { const float* wc_ = a.in[9] + (size_t)l * 4 * 1024; const float* bc_ = a.in[10] + (size_t)l * 1024;
#pragma unroll
          for (int k = 0; k < 2; ++k) { const int i = tid + 512 * k; const int which = i >> 9, j = (i >> 7) & 3, d = i & 127; cwr[k] = wc_[j * 1024 + which * 512 + h * 128 + d]; }
          { const int which = (tid >> 7) & 1, d = tid & 127; cwr[2] = bc_[which * 512 + h * 128 + d]; } }
        u32x4 cst[5];
        if (MODE == 1) { const u32x4* src = (const u32x4*)ml_slot(a.out, item);
#pragma unroll
            for (int k = 0; k < 5; ++k) { const int i = tid + 512 * k; cst[k] = (i < 144 * 16) ? src[i] : (u32x4){0u, 0u, 0u, 0u}; } }
        u32x4 ur[2][5];
#pragma unroll
        for (int which = (MODE == 0 ? 1 : 0); which < 2; ++which)
#pragma unroll
            for (int i = 0; i < 5; ++i) {
                const int sr = s0 + 2 * rg - 3 + i;
                if (sr >= 0) ur[which][i] = *(const u32x4*)(proj + (rowbase + sr) * NINP + h * 128 + 8 * dch + 1536 + 512 * which);
                else ur[which][i] = (u32x4){0u, 0u, 0u, 0u};
            }
        const bf16_t* vp = proj + (rowbase + s0 + vs) * NINP + 2560 + h * 128 + 16 * vc;
        const u32x4 v0 = *(const u32x4*)vp, v1 = *(const u32x4*)(vp + 8);
        float lf = 0.f, li = 0.f;
        if (wid == 0) { lf = gf[s0 + lane]; li = gi[s0 + lane]; }
        cw[tid] = cwr[0]; cw[tid + 512] = cwr[1]; if (tid < 256) cw[1024 + tid] = cwr[2];
        LBAR();
        if (tid < 128) { unsigned o1 = 0x3F803F80u; asm volatile("" : "+v"(o1));
            const u32x4 one = (u32x4){o1, o1, o1, o1}; *(LAS u32x4*)(Vs + (tid >> 1) * ML_VS + 128 + 8 * (tid & 1)) = one; }
        *(LAS u32x4*)(Vs + vs * ML_VS + 16 * vc) = v0; *(LAS u32x4*)(Vs + vs * ML_VS + 16 * vc + 8) = v1;
        if (MODE == 1) {
#pragma unroll
            for (int k = 0; k < 5; ++k) { const int i = tid + 512 * k; if (i < 144 * 16) { const int e = i >> 4, ch = i & 15; *(LAS u32x4*)(Ct + e * ML_CTS + 8 * ch) = cst[k]; } } }
#pragma unroll
        for (int which = (MODE == 0 ? 1 : 0); which < 2; ++which) {
#pragma unroll
            for (int rr = 0; rr < 2; ++rr) {
                f32x4 ya = *(const LAS f32x4*)(cw + 1024 + which * 128 + 8 * dch), yb = *(const LAS f32x4*)(cw + 1024 + which * 128 + 8 * dch + 4);
#pragma unroll
                for (int j = 0; j < 4; ++j) {
                    const u32x4 u = ur[which][rr + j];
                    ya = ya + (f32x4){bflo(u.x), bfhi(u.x), bflo(u.y), bfhi(u.y)} * *(const LAS f32x4*)(cw + which * 512 + j * 128 + 8 * dch);
                    yb = yb + (f32x4){bflo(u.z), bfhi(u.z), bflo(u.w), bfhi(u.w)} * *(const LAS f32x4*)(cw + which * 512 + j * 128 + 8 * dch + 4);
                }
                float y[8] = {ya.x, ya.y, ya.z, ya.w, yb.x, yb.y, yb.z, yb.w};
#pragma unroll
                for (int i = 0; i < 8; ++i) { y[i] = y[i] * sigmoidf_(y[i]); if (!which) y[i] *= q_scale; }
                const int r = 2 * rg + rr;
                u32x4 w; w.x = pk(y[0], y[1]); w.y = pk(y[2], y[3]); w.z = pk(y[4], y[5]); w.w = pk(y[6], y[7]);
                *(LAS u32x4*)((which ? Ks : Qs) + r * ML_QS + 8 * dch) = w;
            }
        }
        if (wid == 0) {
            float bc = lf;
#pragma unroll
            for (int o = 1; o < 64; o <<= 1) { const float t = __shfl_up(bc, o); if (lane >= o) bc += t; }
            const float ct = li - bc; float pm = ct;
#pragma unroll
            for (int o = 1; o < 64; o <<= 1) { const float t = __shfl_up(pm, o); if (lane >= o) pm = fmaxf(pm, t); }
            const float b63 = __shfl(bc, 63);
            if (MODE == 0) {
                const float a_c = b63 + __shfl(pm, 63);
                vec[256 + lane] = fexp(b63 + ct - a_c);
                if (lane == 0) { mlA[item] = a_c; mlG[item] = b63; }
            } else {
                const float m_st = mlM[item];
                const float mt = bc + fmaxf(pm, m_st);
                vec[lane] = bc; vec[64 + lane] = ct; vec[128 + lane] = mt; vec[192 + lane] = fexp(bc + m_st - mt); vec[320 + lane] = fexp(-mt);
            }
        }
    }
    LBAR();
    if (MODE == 1) {
        const int t = 16 * tt + fr;
        bf16x8 qfr[4];
#pragma unroll
        for (int kk = 0; kk < 4; ++kk) qfr[kk] = *(const LAS bf16x8*)(Qs + t * ML_QS + 32 * kk + 8 * fq);
        const float rowterm = vec[t] - vec[128 + t], winter = vec[192 + t], einv = vec[320 + t];
        unsigned pw[2][4];
#pragma unroll
        for (int i = 0; i < 4; ++i) {
            f32x4 sa = (f32x4){0.f, 0.f, 0.f, 0.f};
#pragma unroll
            for (int kk = 0; kk < 4; ++kk) { const bf16x8 kf = *(const LAS bf16x8*)(Ks + (16 * i + fr) * ML_QS + 32 * kk + 8 * fq); sa = mfma16(kf, qfr[kk], sa); }
            const f32x4 ctv = *(const LAS f32x4*)(vec + 64 + 16 * i + 4 * fq);
            float sc[4];
#pragma unroll
            for (int e = 0; e < 4; ++e) { const int s = 16 * i + 4 * fq + e; sc[e] = (s <= t) ? sa[e] * fexp(rowterm + ctv[e]) : 0.f; }
            pw[i >> 1][(i & 1) * 2 + 0] = pk(sc[0], sc[1]); pw[i >> 1][(i & 1) * 2 + 1] = pk(sc[2], sc[3]);
        }
        const bf16x8 P0 = mk8u(pw[0][0], pw[0][1], pw[0][2], pw[0][3]), P1 = mk8u(pw[1][0], pw[1][1], pw[1][2], pw[1][3]);
        f32x4 num[5];
#pragma unroll
        for (int ei = 0; ei < 5; ++ei) {
            const int et = (ei == 4) ? 8 : 4 * half + ei;
            const LAS bf16_t* vr = Vs + (4 * fq + (fr >> 2)) * ML_VS + 16 * et + 4 * (fr & 3);
            const bf16x8 v0 = mk8(trd(vr), trd(vr + 16 * ML_VS)), v1 = mk8(trd(vr + 32 * ML_VS), trd(vr + 48 * ML_VS));
            f32x4 intra = (f32x4){0.f, 0.f, 0.f, 0.f}; intra = mfma16(v0, P0, intra); intra = mfma16(v1, P1, intra);
            f32x4 inter = (f32x4){0.f, 0.f, 0.f, 0.f};
#pragma unroll
            for (int kk = 0; kk < 4; ++kk) { const bf16x8 cf = *(const LAS bf16x8*)(Ct + (16 * et + fr) * ML_CTS + 32 * kk + 8 * fq); inter = mfma16(cf, qfr[kk], inter); }
            num[ei] = intra + inter * winter;
        }
        const float den = fmaxf(fabsf(num[4][0]), einv); const float dinv = 1.f / den;
        float sq = 0.f;
#pragma unroll
        for (int ei = 0; ei < 4; ++ei) { num[ei] = num[ei] * dinv; sq += (num[ei][0] * num[ei][0] + num[ei][1] * num[ei][1]) + (num[ei][2] * num[ei][2] + num[ei][3] * num[ei][3]); }
        sq += __shfl_xor(sq, 16); sq += __shfl_xor(sq, 32);
        if (fq == 0) ex[half * 64 + t] = sq;
        LBAR();
        const float tot = ex[t] + ex[64 + t]; const float rn = __builtin_amdgcn_rsqf(tot * (1.f / 128.f) + EPS);
        const float* gh = a.in[11] + (size_t)l * 512 + h * 128;
        const bf16_t* og = proj + (rowbase + s0 + t) * NINP + 3072 + h * 128;
        bf16_t* op = mixo + (rowbase + s0 + t) * D + 512 + h * 128;
#pragma unroll
        for (int ei = 0; ei < 4; ++ei) {
            const int e0 = 16 * (4 * half + ei) + 4 * fq;
            const f32x4 g4 = *(const f32x4*)(gh + e0); const u32x2 o2 = *(const u32x2*)(og + e0);
            const float y0 = num[ei][0] * rn * g4.x * sigmoidf_(bflo(o2.x)), y1 = num[ei][1] * rn * g4.y * sigmoidf_(bfhi(o2.x));
            const float y2 = num[ei][2] * rn * g4.z * sigmoidf_(bflo(o2.y)), y3 = num[ei][3] * rn * g4.w * sigmoidf_(bfhi(o2.y));
            u32x2 w; w.x = pk(y0, y1); w.y = pk(y2, y3); *(u32x2*)(op + e0) = w;
        }
    }
    if (MODE == 0) {
        bf16x8 kw[2];
#pragma unroll
        for (int kk = 0; kk < 2; ++kk) {
            const LAS bf16_t* kr = Ks + (32 * kk + 8 * fq + (fr >> 2)) * ML_QS + 16 * wid + 4 * (fr & 3);
            const u32x2 k0 = trd(kr), k1 = trd(kr + 4 * ML_QS);
            const f32x4 w0 = *(const LAS f32x4*)(vec + 256 + 32 * kk + 8 * fq), w1 = *(const LAS f32x4*)(vec + 256 + 32 * kk + 8 * fq + 4);
            kw[kk] = mk8u(pk(bflo(k0.x) * w0.x, bfhi(k0.x) * w0.y), pk(bflo(k0.y) * w0.z, bfhi(k0.y) * w0.w),
                          pk(bflo(k1.x) * w1.x, bfhi(k1.x) * w1.y), pk(bflo(k1.y) * w1.z, bfhi(k1.y) * w1.w));
        }
        bf16_t* slot = (bf16_t*)ml_slot(a.out, item);
#pragma unroll
        for (int et = 0; et < 9; ++et) {
            f32x4 cacc = (f32x4){0.f, 0.f, 0.f, 0.f};
#pragma unroll
            for (int kk = 0; kk < 2; ++kk) {
                const LAS bf16_t* vr = Vs + (32 * kk + 8 * fq + (fr >> 2)) * ML_VS + 16 * et + 4 * (fr & 3);
                const bf16x8 vf = mk8(trd(vr), trd(vr + 4 * ML_VS));
                cacc = mfma16(kw[kk], vf, cacc);
            }
            u32x2 w; w.x = pk(cacc[0], cacc[1]); w.y = pk(cacc[2], cacc[3]);
            *(u32x2*)(slot + (size_t)(16 * et + fr) * 128 + 16 * wid + 4 * fq) = w;
        }
    }
    LBAR();
}

__device__ __forceinline__ void mlstm_scan(const Ctx& C, const Args& a) {
    unsigned char* ws = a.ws;
    const float* mlA = (const float*)(ws + WS_MLS); const float* mlG = mlA + 1024; float* mlM = (float*)(ws + WS_MLS) + 2048;
    for (int w = C.blk; w < 256; w += C.G) {
        const int bh = w >> 3, slice = w & 7;
        if (C.tid < 384) {
            const int widx = slice * 1152 + C.tid;
            float st[6] = {0.f, 0.f, 0.f, 0.f, 0.f, 0.f}; float m = 0.f;
            unsigned sw[32][3];
#pragma unroll
            for (int cc = 0; cc < 32; ++cc) { const unsigned* sp = (const unsigned*)ml_slot(a.out, bh * 32 + cc) + widx;
#pragma unroll
                for (int j = 0; j < 3; ++j) sw[cc][j] = sp[384 * j]; }
#pragma unroll
            for (int cc = 0; cc < 32; ++cc) {
                const int item = bh * 32 + cc;
                const float a_c = mlA[item], g_c = mlG[item];
                const float m_new = fmaxf(g_c + m, a_c), al = fexp(g_c + m - m_new), be = fexp(a_c - m_new);
                unsigned* dp = (unsigned*)ml_slot(a.out, item) + widx;
#pragma unroll
                for (int j = 0; j < 3; ++j) {
                    dp[384 * j] = pk(st[2 * j], st[2 * j + 1]);
                    st[2 * j] = al * st[2 * j] + be * bflo(sw[cc][j]); st[2 * j + 1] = al * st[2 * j + 1] + be * bfhi(sw[cc][j]);
                }
                if (slice == 0 && C.tid == 0) mlM[item] = m;
                m = m_new;
            }
        }
    }
}

constexpr int XA_KS = 264;
constexpr int XA_BUF = 64 * XA_KS * 2;
template <bool QL = false>
__device__ __forceinline__ void xattn_unit(const Ctx& C, const bf16_t* qn, const bf16_t* kv, bf16_t* obuf, int l, int b, int h, int qb, const LAS bf16_t* qlds = nullptr, int kvoff = 0) {
    const int tid = C.tid, lane = C.lane, wid = C.wave, fr = lane & 15, fq = lane >> 4;
    const int t = qb * 128 + wid * 16 + fr;
    const size_t qrow = (size_t)b * SEQ + t;
    bf16x8 qf[8];
    if (QL) { const LAS bf16_t* qp = qlds + (wid * 16 + fr) * XA_KS + 8 * fq;
#pragma unroll
      for (int kk = 0; kk < 8; ++kk) qf[kk] = *(const LAS bf16x8*)(qp + 32 * kk); }
    else { const bf16_t* qp = qn + qrow * D + h * 256 + 8 * fq;
#pragma unroll
      for (int kk = 0; kk < 8; ++kk) qf[kk] = *(const bf16x8*)(qp + 32 * kk); }
    const int ss_ = tid >> 3, sc_ = tid & 7;
    const bf16_t* kbase = kv + ((size_t)b * MEML + ss_) * 4096 + l * 2048 + h * 256 + 8 * sc_;
#define XA_SRC(s_) (((s_) < 4) ? kbase + (size_t)(64 * (s_)) * 4096 : kbase + 1024 + (size_t)(64 * ((s_) - 4)) * 4096)
    u32x4 st[2][4];
#pragma unroll
    for (int i = 0; i < 4; ++i) { st[0][i] = *(const u32x4*)(XA_SRC(0) + 64 * i); st[1][i] = *(const u32x4*)(XA_SRC(1) + 64 * i); }
    f32x4 S[16];
    int cur = 0;
#pragma unroll
    for (int c = 0; c < 4; ++c) {
        LAS bf16_t* Kc = (LAS bf16_t*)(C.lds + kvoff + cur * XA_BUF);
#pragma unroll
        for (int i = 0; i < 4; ++i) *(LAS u32x4*)(Kc + ss_ * XA_KS + 8 * sc_ + 64 * i) = st[c & 1][i];
        { const bf16_t* nb = XA_SRC(c + 2);
#pragma unroll
          for (int i = 0; i < 4; ++i) st[c & 1][i] = *(const u32x4*)(nb + 64 * i); }
        LBAR();
#pragma unroll
        for (int i = 0; i < 4; ++i) {
            f32x4 sa = (f32x4){0.f, 0.f, 0.f, 0.f};
#pragma unroll
            for (int kk = 0; kk < 8; ++kk) { const bf16x8 kf = *(const LAS bf16x8*)(Kc + (16 * i + fr) * XA_KS + 32 * kk + 8 * fq); sa = mfma16(kf, qf[kk], sa); }
            S[4 * c + i] = sa;
        }
        cur ^= 1;
    }
    float mx = -1e30f;
#pragma unroll
    for (int i = 0; i < 16; ++i) mx = fmaxf(mx, fmaxf(fmaxf(S[i][0], S[i][1]), fmaxf(S[i][2], S[i][3])));
    mx = fmaxf(mx, __shfl_xor(mx, 16)); mx = fmaxf(mx, __shfl_xor(mx, 32));
    float sum = 0.f;
#pragma unroll
    for (int i = 0; i < 16; ++i)
#pragma unroll
        for (int e = 0; e < 4; ++e) { const float p = fexp((S[i][e] - mx) * 0.0625f); S[i][e] = p; sum += p; }
    sum += __shfl_xor(sum, 16); sum += __shfl_xor(sum, 32);
    bf16x8 pf[8];
#pragma unroll
    for (int k2 = 0; k2 < 8; ++k2) pf[k2] = mk8u(pk(S[2 * k2][0], S[2 * k2][1]), pk(S[2 * k2][2], S[2 * k2][3]), pk(S[2 * k2 + 1][0], S[2 * k2 + 1][1]), pk(S[2 * k2 + 1][2], S[2 * k2 + 1][3]));
    f32x4 O[16];
#pragma unroll
    for (int i = 0; i < 16; ++i) O[i] = (f32x4){0.f, 0.f, 0.f, 0.f};
#pragma unroll
    for (int c = 0; c < 4; ++c) {
        LAS bf16_t* Vc = (LAS bf16_t*)(C.lds + kvoff + cur * XA_BUF);
#pragma unroll
        for (int i = 0; i < 4; ++i) *(LAS u32x4*)(Vc + ss_ * XA_KS + 8 * sc_ + 64 * i) = st[c & 1][i];
        if (c < 2) { const bf16_t* nb = XA_SRC(c + 6);
#pragma unroll
            for (int i = 0; i < 4; ++i) st[c & 1][i] = *(const u32x4*)(nb + 64 * i); }
        LBAR();
#pragma unroll
        for (int dt = 0; dt < 16; ++dt) {
            const LAS bf16_t* vr = Vc + (4 * fq + (fr >> 2)) * XA_KS + 16 * dt + 4 * (fr & 3);
            const bf16x8 v0 = mk8(trd(vr), trd(vr + 16 * XA_KS)), v1 = mk8(trd(vr + 32 * XA_KS), trd(vr + 48 * XA_KS));
            O[dt] = mfma16(v0, pf[2 * c], O[dt]); O[dt] = mfma16(v1, pf[2 * c + 1], O[dt]);
        }
        cur ^= 1;
    }
    const float inv = 1.f / sum;
    bf16_t* op = obuf + qrow * D + h * 256 + 4 * fq;
#pragma unroll
    for (int dt = 0; dt < 16; ++dt) { u32x2 w; w.x = pk(O[dt][0] * inv, O[dt][1] * inv); w.y = pk(O[dt][2] * inv, O[dt][3] * inv); *(u32x2*)(op + 16 * dt) = w; }
    LBAR();
}

struct EpiQXattn {
    static constexpr bool USE_RT = true, AFTER_DRAIN = true;
    const float* ss; const float* gain; LAS float* P; LAS unsigned char* lds; const bf16_t* kv; bf16_t* obuf; int l;
    __device__ __forceinline__ void operator()(const pg8::Acc& acc, const pg8::Unit& u, int wr, int wc, int fr, int fq, const pg8::RowTab& T) const {
        using namespace pg8;
        f32x4 g[2][2];
#pragma unroll
        for (int bj = 0; bj < 2; ++bj)
#pragma unroll
            for (int n = 0; n < 2; ++n) g[bj][n] = *(const f32x4*)(gain + bj * HALF + wc * 32 + 8 * fq + 4 * n);
        float rn[2][4];
#pragma unroll
        for (int ai = 0; ai < 2; ++ai)
#pragma unroll
            for (int m = 0; m < 4; ++m) {
                const float r = rs_get(T, ss, u, ai * HALF + wr * 64 + m * 16 + fr); rn[ai][m] = r; float sq = 0.f;
#pragma unroll
                for (int bj = 0; bj < 2; ++bj)
#pragma unroll
                    for (int n = 0; n < 2; ++n) { const f32x4 v = acc[ai][bj][m][n] * r; sq += (v.x * v.x + v.y * v.y) + (v.z * v.z + v.w * v.w); }
                sq += __shfl_xor(sq, 16); sq += __shfl_xor(sq, 32);
                if (fq == 0) P[(ai * HALF + wr * 64 + m * 16 + fr) * 4 + wc] = sq;
            }
        LBAR();
#pragma unroll
        for (int ai = 0; ai < 2; ++ai)
#pragma unroll
            for (int m = 0; m < 4; ++m) { const f32x4 p = *(const LAS f32x4*)(P + (ai * HALF + wr * 64 + m * 16 + fr) * 4);
                rn[ai][m] *= __builtin_amdgcn_rsqf(((p.x + p.y) + (p.z + p.w)) * (1.f / 256.f) + EPS); }
        Ctx C2; { int t_ = threadIdx.x; asm volatile("" : "+v"(t_)); C2.tid = t_; C2.lane = t_ & 63; C2.wave = __builtin_amdgcn_readfirstlane(t_ >> 6); } C2.lds = lds; C2.G = gridDim.x; C2.blk = blockIdx.x;
        LAS bf16_t* Qs = (LAS bf16_t*)lds;
        const int b = u.pm >> 3, h = u.pn;
        u32x4 qw[2][4][2];
#pragma unroll
        for (int hf = 0; hf < 2; ++hf)
#pragma unroll
            for (int m = 0; m < 4; ++m)
#pragma unroll
                for (int bj = 0; bj < 2; ++bj) {
                    const f32x4 a = acc[hf][bj][m][0] * rn[hf][m] * g[bj][0], c = acc[hf][bj][m][1] * rn[hf][m] * g[bj][1];
                    u32x4 w; w.x = pk(a.x, a.y); w.y = pk(a.z, a.w); w.z = pk(c.x, c.y); w.w = pk(c.z, c.w); qw[hf][m][bj] = w;
                }
#pragma unroll
        for (int hf = 0; hf < 2; ++hf) {
            LBAR();
#pragma unroll
            for (int m = 0; m < 4; ++m)
#pragma unroll
                for (int bj = 0; bj < 2; ++bj) *(LAS u32x4*)(Qs + (wr * 64 + m * 16 + fr) * XA_KS + bj * HALF + wc * 32 + 8 * fq) = qw[hf][m][bj];
            LBAR();
            xattn_unit<true>(C2, nullptr, kv, obuf, l, b, h, (u.pm & 7) * 2 + hf, Qs, 128 * XA_KS * 2);
        }
    }
};
static_assert(128 * XA_KS * 2 + 2 * XA_BUF <= MISC_OFF, "query tile + K/V chunk buffers below the LDS control words");

#define XB_TMO      128
#define XB_XCNT(j)  (256  + 64 * (j))
#define XB_XSUB(j)  (1280 + 64 * (j))
#define XB_XGEN(j)  (2304 + 64 * (j))
#define XB_TOP      3328
#define XB_TOPGEN   3392
#define XCD_BAR_WORDS 3456
#define XB_SPIN_CAP (1u << 22)
constexpr int CW_BAR = 4096;
constexpr size_t CTL_ZERO_BYTES = 64 * 1024;
__device__ __forceinline__ unsigned xb_ld(unsigned* p)              { return __hip_atomic_load(p, __ATOMIC_RELAXED, __HIP_MEMORY_SCOPE_AGENT); }
__device__ __forceinline__ unsigned xb_add(unsigned* p, unsigned v) { return __hip_atomic_fetch_add(p, v, __ATOMIC_RELAXED, __HIP_MEMORY_SCOPE_AGENT); }
__device__ __forceinline__ unsigned xb_xcc_id() { return (unsigned)__builtin_amdgcn_s_getreg((3 << 11) | 20) & 0xFu; }
#define XB_SPIN(cond, bar) do { unsigned _sp = 0; while (cond) { __builtin_amdgcn_s_sleep(1); \
    if ((++_sp & 255u) == 0u) { if (xb_ld(&(bar)[XB_TMO])) break; if (_sp > XB_SPIN_CAP) { atomicAdd(&(bar)[XB_TMO], 1u); break; } } } } while (0)
struct XcdBarrier { unsigned* bar; unsigned x; volatile LAS unsigned* st; };
__device__ __forceinline__ XcdBarrier xcd_barrier_post(unsigned* bar, volatile LAS unsigned* st) {
    XcdBarrier b; b.bar = bar; b.x = xb_xcc_id(); b.st = st;
    if (threadIdx.x == 0) (void)xb_add(&bar[XB_XCNT(b.x)], 1u);
    return b;
}
__device__ __forceinline__ void xcd_barrier_complete(unsigned* bar, unsigned x, unsigned& nloc, unsigned& nx) {
    const unsigned G = gridDim.x * gridDim.y * gridDim.z;
    unsigned sum, cnt, mine, sp = 0u;
    for (;;) {
        sum = 0u; cnt = 0u; mine = 0u;
#pragma unroll
        for (unsigned j = 0; j < 16; ++j) { const unsigned c = xb_ld(&bar[XB_XCNT(j)]); sum += c; cnt += (c > 0u) ? 1u : 0u; mine = (j == x) ? c : mine; }
        if (sum == G) break;
        __builtin_amdgcn_s_sleep(1);
        if ((++sp & 255u) == 0u) { if (xb_ld(&bar[XB_TMO])) break; if (sp > XB_SPIN_CAP) { atomicAdd(&bar[XB_TMO], 1u); break; } }
    }
    nloc = mine > 0u ? mine : 1u; nx = cnt > 0u ? cnt : 1u;
}
__device__ __forceinline__ void xcd_barrier(const XcdBarrier& b) {
    asm volatile("s_waitcnt vmcnt(0)" ::: "memory");
    __syncthreads();
    if (threadIdx.x == 0) {
        unsigned* bar = b.bar;
        __builtin_amdgcn_s_waitcnt(0);
        unsigned nloc = b.st[0], nx = b.st[1];
        if (nloc == 0u) { xcd_barrier_complete(bar, b.x, nloc, nx); b.st[0] = nloc; b.st[1] = nx; }
        const unsigned old = xb_add(&bar[XB_XSUB(b.x)], 1u);
        const unsigned gen = old / nloc;
        if (old + 1u == (gen + 1u) * nloc) {
            __builtin_amdgcn_fence(__ATOMIC_RELEASE, "agent");
            asm volatile("s_waitcnt vmcnt(0)" ::: "memory");
            const unsigned og = xb_add(&bar[XB_TOP], 1u);
            const unsigned tg = og / nx;
            if (og + 1u == (tg + 1u) * nx) xb_add(&bar[XB_TOPGEN], 1u);
            else XB_SPIN(xb_ld(&bar[XB_TOPGEN]) == tg, bar);
            __builtin_amdgcn_fence(__ATOMIC_ACQUIRE, "agent");
            xb_add(&bar[XB_XGEN(b.x)], 1u);
            asm volatile("s_waitcnt vmcnt(0)" ::: "memory");
        } else {
            XB_SPIN(xb_ld(&bar[XB_XGEN(b.x)]) == gen, bar);
            __builtin_amdgcn_fence(__ATOMIC_ACQUIRE, "agent");
            asm volatile("s_waitcnt vmcnt(0)" ::: "memory");
        }
    }
    __syncthreads();
}

__global__ void __launch_bounds__(512, 2) fwd_kernel(Args a) {
    extern __shared__ __attribute__((aligned(16))) unsigned char lds_raw[];
    Ctx C; C.lds = (LAS unsigned char*)lds_raw; C.G = gridDim.x; C.blk = blockIdx.x;
    unsigned char* ws = a.ws;
    const int lo = a.ph_lo, hi = a.ph_hi;
#define xb ((bf16_t*)(a.ws + WS_XB))
#define big ((bf16_t*)(a.ws + WS_BIG))
#define mixo ((bf16_t*)(a.ws + WS_MIXO))
#define qn big
#define ob (big + (size_t)M * D)
#define ssb0 ((float*)(a.ws + WS_SS))
#define ssb1 (ssb0 + (size_t)M * 4)
    LAS float* P = (LAS float*)(C.lds + XSCR_OFF);
    volatile LAS int* misc = (volatile LAS int*)(C.lds + MISC_OFF);
    XcdBarrier xbar; xbar.bar = nullptr; xbar.x = 0; xbar.st = nullptr;
    if (hi - lo > 1) {
        if (threadIdx.x < 2) misc[8 + threadIdx.x] = 0;
        __syncthreads();
        xbar = xcd_barrier_post((unsigned*)(ws + WS_CTL) + CW_BAR, (volatile LAS unsigned*)(misc + 8));
    }
#ifndef PROBE_DUP_LO
#define PROBE_DUP_LO 0
#define PROBE_DUP_N 0
#endif
    for (int it = lo; it < hi; ++it) {
        const int rep = (PROBE_DUP_N > 0 && it >= PROBE_DUP_LO + PROBE_DUP_N && it < PROBE_DUP_LO + 2 * PROBE_DUP_N) ? 1 : 0;
        const int ph = (PROBE_DUP_N > 0 && it >= PROBE_DUP_LO + PROBE_DUP_N) ? it - PROBE_DUP_N : it;
        const int l = ph / 13, p = ph % 13;
#define RELAUNDER() do { int t_ = threadIdx.x; asm volatile("" : "+v"(t_)); C.tid = t_; C.lane = t_ & 63; C.wave = __builtin_amdgcn_readfirstlane(t_ >> 6); } while (0)
        RELAUNDER();
        if (p == 0) conv_phase(C, a, l);
        else if (p == 1 || p == 11) {
            pg8::Gemm g{xb, (const bf16_t*)(ws + (p == 1 ? W_GU1 : W_GU2)), M, NGU, D}; pg8::StaticOrder S; S.init(M, NGU, C.G, C.blk);
            pg8::EpiSwiglu E{big, p == 1 ? ssb0 : ssb1};
            pg8::gemm_phase(C.lds, g, S, E);
            if (ph == 1 && rep == 0) {
                pg8::Gemm g2{(const bf16_t*)(ws + WS_MEMB), (const bf16_t*)(ws + WS_WKV), MM, 4096, D}; pg8::StaticOrder S2; S2.init(MM, 4096, C.G, (C.blk + C.G / 2) % C.G);
                pg8::EpiHeadNorm E2{(bf16_t*)(ws + WS_KV), 4096, (const float*)(ws + WS_SSM), a.in[19], a.in[19] + 256, P};
                pg8::gemm_phase(C.lds, g2, S2, E2);
            }
        } else if (p == 2 || p == 12) {
            pg8::Gemm g{big, (const bf16_t*)(ws + (p == 2 ? W_D1 : W_D2)), M, D, FF}; pg8::StaticOrder S; S.init(M, D, C.G, C.blk);
            if (ph == 2) { pg8::EpiResid<true, false> E{a.in[0], a.out, xb, ssb1, 0.5f, P}; pg8::gemm_phase(C.lds, g, S, E); }
            else if (ph == NPH - 1) { pg8::EpiResid<false, true> E{a.in[0], a.out, xb, ssb0, 0.5f, P}; pg8::gemm_phase(C.lds, g, S, E); }
            else { pg8::EpiResid<false, false> E{a.in[0], a.out, xb, p == 2 ? ssb1 : ssb0, 0.5f, P}; pg8::gemm_phase(C.lds, g, S, E); }
        } else if (p == 3) {
            pg8::Gemm g{xb, (const bf16_t*)(ws + W_IN), M, NINP, D}; pg8::StaticOrder S; S.init(M, NINP, C.G, C.blk);
            pg8::EpiProj E{big, NINP, ssb1};
            pg8::gemm_phase(C.lds, g, S, E);
            RELAUNDER();
            gates_pass(C, a, l, ssb1);
        } else if (p == 4 || p == 6) {
            unsigned* ctr = (unsigned*)(ws + WS_CTL) + 64 * (2 * l + (p == 6 ? 1 : 0) + 4 * rep);
            if (C.tid == 0) misc[0] = (int)atomicAdd(ctr, 1u);
            LBAR();
            int idx = misc[0];
            LBAR();
            while (idx < 1536) {
                unsigned nxt = 0u;
                if (C.tid == 0) nxt = atomicAdd(ctr, 1u);
                if (idx < 1024) { if (p == 4) mlstm_item<0>(C, a, l, idx); else mlstm_item<1>(C, a, l, idx); }
                else { const int u2 = 2 * (idx - 1024) + (p == 6 ? 1 : 0); const int qb = 15 - (u2 >> 6), bh = u2 & 63; sb_unit(C, big, mixo, bh >> 3, bh & 7, qb); }
                if (C.tid == 0) misc[0] = (int)nxt;
                LBAR();
                idx = misc[0];
                LBAR();
            }
        } else if (p == 5) {
            mlstm_scan(C, a);
        } else if (p == 7) {
            pg8::Gemm g{mixo, (const bf16_t*)(ws + W_OUT), M, D, D}; pg8::StaticOrder S; S.init(M, D, C.G, C.blk);
            pg8::EpiResid<false, false> E{a.in[0], a.out, xb, ssb0, 1.0f, P};
            pg8::gemm_phase(C.lds, g, S, E);
        } else if (p == 8) {
            pg8::Gemm g{xb, (const bf16_t*)(ws + W_XQ), M, D, D}; pg8::StaticOrder S; S.init(M, D, C.G, C.blk);
            if ((M / 256) * (D / 256) == C.G) {
                EpiQXattn EQ{ssb0, a.in[18] + l * 256, P, C.lds, (const bf16_t*)(ws + WS_KV), ob, l};
                pg8::gemm_phase(C.lds, g, S, EQ);
            } else {
            pg8::EpiHeadNorm E{qn, D, ssb0, a.in[18] + l * 256, a.in[18] + l * 256, P};
            pg8::gemm_phase(C.lds, g, S, E);
            asm volatile("s_waitcnt vmcnt(0)" ::: "memory"); __syncthreads();
            RELAUNDER();
            { pg8::Unit u; for (int i = 0; S.next(i, u); ++i) { const int b = u.pm >> 3, qb0 = (u.pm & 7) * 2;
                xattn_unit(C, qn, (const bf16_t*)(ws + WS_KV), ob, l, b, u.pn, qb0); xattn_unit(C, qn, (const bf16_t*)(ws + WS_KV), ob, l, b, u.pn, qb0 + 1); } }
            }
        } else if (p == 9) {
        } else if (p == 10) {
            pg8::Gemm g{ob, (const bf16_t*)(ws + W_XO), M, D, D}; pg8::StaticOrder S; S.init(M, D, C.G, C.blk);
            pg8::EpiResid<false, false> E{a.in[0], a.out, xb, ssb1, 1.0f, P};
            pg8::gemm_phase(C.lds, g, S, E);
        }
        if (it + 1 < hi && p != 9) {
            if (lo < 0) cg::this_grid().sync();
            xcd_barrier(xbar);
        }
    }
}

#undef xb
#undef big
#undef mixo
#undef qn
#undef ob
#undef ssb0
#undef ssb1
extern "C" void kernel_launch(void* const* d_in, const int* in_sizes, int n_in, void* d_out, int out_size, void* d_ws, size_t ws_size, hipStream_t stream) {
    static int grid = 0;
    if (grid == 0) {
        if (n_in != 25 || out_size != M * D || ws_size < WS_END) { fprintf(stderr, "kernel_launch: unexpected problem (n_in %d out %d ws %zu)\n", n_in, out_size, ws_size); grid = -1; return; }
        int dev = 0, cus = 0, per_cu = 0;
        hipGetDevice(&dev); hipDeviceGetAttribute(&cus, hipDeviceAttributeMultiprocessorCount, dev);
        hipFuncSetAttribute((const void*)fwd_kernel, hipFuncAttributeMaxDynamicSharedMemorySize, LDS_BYTES);
        hipOccupancyMaxActiveBlocksPerMultiprocessor(&per_cu, (const void*)fwd_kernel, 512, LDS_BYTES);
        if (per_cu < 1) per_cu = 1;
        grid = cus * per_cu;
        (void)hipGetLastError();
        { const int shp[4][2] = {{M, NGU}, {M, NINP}, {M, D}, {MM, 4096}}; bool ok = true;
          for (int s = 0; s < 4 && ok; ++s) for (int c = 0; c < grid && ok; ++c) { pg8::StaticOrder S; S.init(shp[s][0], shp[s][1], grid, c); pg8::Unit u; int base = -1;
              for (int i = 0; S.next(i, u); ++i) { if (base < 0) base = (u.pm >> 3) << 3; if (u.pm < base || u.pm >= base + 8) ok = false; } }
          if (!ok) { fprintf(stderr, "kernel_launch: unit order does not keep a workgroup inside one 8-panel group on a %d-workgroup grid; nothing launched\n", grid); grid = -1; return; } }
    }
    if (grid < 0) return;
    if (hipMemsetAsync((char*)d_ws + WS_CTL, 0, CTL_ZERO_BYTES, stream) != hipSuccess) { fprintf(stderr, "kernel_launch: memset failed\n"); return; }
    Args a{};
    for (int i = 0; i < 25; ++i) a.in[i] = (const float*)d_in[i];
    a.out = (float*)d_out; a.ws = (unsigned char*)d_ws;
#if MK_ONE
    a.ph_lo = 0; a.ph_hi = NPH + PROBE_DUP_N;
    void* args[] = {&a};
    hipError_t e = hipLaunchCooperativeKernel((const void*)fwd_kernel, dim3(grid), dim3(512), args, LDS_BYTES, stream);
    if (e != hipSuccess) fprintf(stderr, "cooperative launch failed: %s (grid %d)\n", hipGetErrorString(e), grid);
#else
#ifndef PH_LIMIT
#define PH_LIMIT NPH
#endif
    for (int ph = 0; ph < PH_LIMIT; ++ph) { a.ph_lo = ph; a.ph_hi = ph + 1; hipLaunchKernelGGL(fwd_kernel, dim3(grid), dim3(512), LDS_BYTES, stream, a); }
#endif
}
```

```cpp
#include <hip/hip_runtime.h>
#include <hip/hip_cooperative_groups.h>
#include <cstdio>
#include <cstdint>
namespace cg = cooperative_groups;

#ifndef MK_ONE
#define MK_ONE 1
#endif

#ifndef PH_MASK
#define PH_MASK 0x1ff
#endif
#define PH_ON(k) (((PH_MASK) >> (k)) & 1)
#define LAS __attribute__((address_space(3)))
typedef unsigned short bf16_t;
typedef short bf16x8 __attribute__((ext_vector_type(8)));
typedef float f32x4 __attribute__((ext_vector_type(4)));
typedef unsigned u32x4 __attribute__((ext_vector_type(4)));
typedef unsigned u32x2 __attribute__((ext_vector_type(2)));

constexpr int BATCH = 8, SEQ = 2048, D = 1024, M = BATCH * SEQ, FF = 2816, NGU = 2 * FF, NIN = 3592, NINP = 3584, MEML = 256, MM = BATCH * MEML;
constexpr float EPS = 1e-6f;
constexpr int NPH = 26;

constexpr size_t MiB = 1u << 20;
constexpr size_t WS_CTL = 0;
constexpr size_t WS_SS = 64 * 1024;
constexpr size_t WS_SSM = WS_SS + 2 * MiB;
constexpr size_t WS_GI = WS_SSM + 128 * 1024;
constexpr size_t WS_GF = WS_GI + 256 * 1024;
constexpr size_t WS_WG = WS_GF + 256 * 1024;
constexpr size_t WS_MLS = WS_WG + 64 * 1024;
constexpr size_t WS_WGB = WS_MLS + 16 * 1024;
constexpr size_t WS_W = 3 * MiB;
constexpr size_t W_GU1 = WS_W, W_D1 = W_GU1 + 11 * MiB, W_IN = W_D1 + 5 * MiB + 512 * 1024, W_OUT = W_IN + 7 * MiB, W_XQ = W_OUT + 2 * MiB, W_XO = W_XQ + 2 * MiB,
                 W_GU2 = W_XO + 2 * MiB, W_D2 = W_GU2 + 11 * MiB, W_END = W_D2 + 5 * MiB + 512 * 1024;
constexpr size_t WS_WKV = 49 * MiB;
constexpr size_t WS_XB = 57 * MiB;
constexpr size_t WS_BIG = 89 * MiB;
constexpr size_t GRP_STRIDE = 14 * MiB;
constexpr size_t GX_H = GRP_STRIDE - 2048 * (size_t)FF * 2, GX_Q = GRP_STRIDE - 2048 * (size_t)D * 2;
constexpr size_t WS_MIXO = 201 * MiB;
constexpr size_t WS_KV = 233 * MiB;
constexpr size_t WS_MEMB = 249 * MiB;
constexpr size_t WS_END = 254 * MiB;
static_assert(W_END == 49 * MiB, "weight map");

constexpr int RING_BYTES = 131072;
constexpr int XSCR_OFF = RING_BYTES;
constexpr int MISC_OFF = XSCR_OFF + 4096;
constexpr int RT_OFF = 139264;
constexpr int LDS_BYTES = 147456;

typedef float f32x2_t __attribute__((ext_vector_type(2)));
typedef __bf16 bf16x2_t __attribute__((ext_vector_type(2)));
__device__ __forceinline__ unsigned pk(float lo, float hi) { f32x2_t v = {lo, hi}; bf16x2_t b = __builtin_convertvector(v, bf16x2_t); return __builtin_bit_cast(unsigned, b); }
__device__ __forceinline__ float bflo(unsigned u) { return __uint_as_float(u << 16); }
__device__ __forceinline__ float bfhi(unsigned u) { return __uint_as_float(u & 0xffff0000u); }
__device__ __forceinline__ float fexp(float x) { return __builtin_amdgcn_exp2f(x * 1.4426950408889634f); }
__device__ __forceinline__ float flog(float x) { return __builtin_amdgcn_logf(x) * 0.6931471805599453f; }
__device__ __forceinline__ float frcp(float x) { return __builtin_amdgcn_rcpf(x); }
__device__ __forceinline__ float softplus(float z) { return fmaxf(z, 0.f) + flog(1.f + fexp(-fabsf(z))); }
__device__ __forceinline__ float sigmoidf_(float z) { return frcp(1.f + fexp(-z)); }
__device__ __forceinline__ float wave_sum(float v) {
#pragma unroll
    for (int o = 1; o < 64; o <<= 1) v += __shfl_xor(v, o);
    return v;
}
__device__ __forceinline__ f32x4 mfma16(bf16x8 a, bf16x8 b, f32x4 c) { return __builtin_amdgcn_mfma_f32_16x16x32_bf16(a, b, c, 0, 0, 0); }
__device__ __forceinline__ bf16x8 mk8(u32x2 a, u32x2 b) { u32x4 t; t.x = a.x; t.y = a.y; t.z = b.x; t.w = b.y; return __builtin_bit_cast(bf16x8, t); }
__device__ __forceinline__ bf16x8 mk8u(unsigned a, unsigned b, unsigned c, unsigned d) { u32x4 t; t.x = a; t.y = b; t.z = c; t.w = d; return __builtin_bit_cast(bf16x8, t); }
typedef short v4i16_t __attribute__((ext_vector_type(4)));
__device__ __forceinline__ u32x2 trd(const LAS bf16_t* p) { return __builtin_bit_cast(u32x2, __builtin_amdgcn_ds_read_tr16_b64_v4i16((LAS v4i16_t*)p)); }
__device__ __forceinline__ float rowscale(const float* ss, int row) {
    const f32x4 a = *(const f32x4*)(ss + (size_t)row * 4);
    return __builtin_amdgcn_rsqf(((a.x + a.y) + (a.z + a.w)) * (1.f / 1024.f) + EPS);
}
#define LDS_WAIT() asm volatile("s_waitcnt lgkmcnt(0)" ::: "memory")
#define WG_BAR() do { asm volatile("s_waitcnt vmcnt(0) lgkmcnt(0)" ::: "memory"); __builtin_amdgcn_s_barrier(); asm volatile("" ::: "memory"); } while (0)
#define LBAR() do { asm volatile("s_waitcnt lgkmcnt(0)" ::: "memory"); __builtin_amdgcn_s_barrier(); asm volatile("" ::: "memory"); } while (0)

namespace pg8 {
constexpr int BM = 256, BK = 64, HALF = 128, HTB = HALF * BK * 2, STAGE_BYTES = 8 * HTB, NXCD = 8, WGM = 8;
__host__ __device__ __forceinline__ int lds_byte(int r, int c) { const int st = (r >> 4) * 2 + (c >> 5), rr = r & 15, cc = c & 31, ob = rr * 64 + cc * 2; return st * 1024 + (ob ^ (((ob >> 9) & 1) << 5)); }
__host__ __device__ __forceinline__ void stage_rc(int b, int& R, int& C) { const int st = b / 1024, sb = b % 1024, swz = sb ^ (((sb >> 9) & 1) << 5); R = (st >> 1) * 16 + swz / 64; C = (st & 1) * 32 + (swz % 64) / 2; }
__host__ __device__ __forceinline__ int perm32(int rho) { const int n = rho >> 4, i = rho & 15; return 8 * (i >> 2) + 4 * n + (i & 3); }
struct Unit { int pm, pn; };
struct Gemm { const bf16_t* A; const bf16_t* Bt; int M, N, K; size_t gx = 0; };
struct StaticOrder {
    int nM, nN, nwg, G, c;
    __host__ __device__ void init(int M_, int N_, int G_, int c_) { nM = M_ / BM; nN = N_ / BM; nwg = nM * nN; G = G_; c = c_; }
    __host__ __device__ bool next(int i, Unit& u) const {
        const long L = (long)i * G + c; if (L >= nwg) return false;
        int wgid = (int)L; { const int q = nwg / NXCD, r = nwg % NXCD, xcd = wgid % NXCD, off = wgid / NXCD; wgid = (xcd < r ? xcd * (q + 1) : r * (q + 1) + (xcd - r) * q) + off; }
        const int nig = WGM * nN, gid = wgid / nig, fm = gid * WGM, gsz = (nM - fm) < WGM ? (nM - fm) : WGM;
        u.pm = fm + ((wgid % nig) % gsz); u.pn = (wgid % nig) / gsz; return true;
    }
};
typedef f32x4 Acc[2][2][4][2];

struct RowTab { const LAS float* rt; int base_pm; };
__device__ __forceinline__ float rs_get(const RowTab& T, const float* ss, const Unit& u, int rl) {
    return T.rt[((u.pm - T.base_pm) & 7) * BM + rl];
}
struct EpiSwiglu {
    static constexpr bool USE_RT = true, AFTER_DRAIN = false;
    bf16_t* H; const float* ss;
    __device__ __forceinline__ void operator()(const Acc& acc, const Unit& u, int wr, int wc, int fr, int fq, const RowTab& T) const {
        const int row0 = u.pm * BM + wr * 64 + fr, col0 = u.pn * HALF + wc * 32 + 8 * fq;
#pragma unroll
        for (int ai = 0; ai < 2; ++ai)
#pragma unroll
            for (int m = 0; m < 4; ++m) {
                const int row = row0 + ai * HALF + m * 16; const float r = rs_get(T, ss, u, ai * HALF + wr * 64 + m * 16 + fr);
                const float rs_ = r * -1.4426950408889634f, r2 = r * r;
                float hv[8];
#pragma unroll
                for (int n = 0; n < 2; ++n)
#pragma unroll
                    for (int e = 0; e < 4; ++e) { const float g = acc[ai][0][m][n][e], up = acc[ai][1][m][n][e]; hv[4 * n + e] = (g * up) * (r2 * frcp(1.f + __builtin_amdgcn_exp2f(g * rs_))); }
                u32x4 w; w.x = pk(hv[0], hv[1]); w.y = pk(hv[2], hv[3]); w.z = pk(hv[4], hv[5]); w.w = pk(hv[6], hv[7]);
                *(u32x4*)(H + (size_t)row * FF + (size_t)(u.pm >> 3) * (GX_H / 2) + col0) = w;
            }
    }
};
template <bool IN_F32, bool OUT_F32>
struct EpiResid {
    static constexpr bool USE_RT = false, AFTER_DRAIN = false; static constexpr const float* ss = nullptr;
    const float* xin; float* xout; bf16_t* xb; float* ssout; float alpha; LAS float* P;
    __device__ __forceinline__ void operator()(const Acc& acc, const Unit& u, int wr, int wc, int fr, int fq, const RowTab& T) const {
        const int row0 = u.pm * BM + wr * 64 + fr, col0 = u.pn * BM + wc * 32 + 8 * fq;
#pragma unroll
        for (int ai = 0; ai < 2; ++ai) {
            u32x4 xh[4][2];
            if (!IN_F32) {
#pragma unroll
                for (int m = 0; m < 4; ++m)
#pragma unroll
                    for (int bj = 0; bj < 2; ++bj) xh[m][bj] = *(const u32x4*)(xb + (size_t)(row0 + ai * HALF + m * 16) * D + col0 + bj * HALF);
            }
            f32x4 xv[4][2][2];
            if (IN_F32) {
#pragma unroll
                for (int m = 0; m < 4; ++m)
#pragma unroll
                    for (int bj = 0; bj < 2; ++bj) { const size_t off = (size_t)(row0 + ai * HALF + m * 16) * D + col0 + bj * HALF; xv[m][bj][0] = *(const f32x4*)(xin + off); xv[m][bj][1] = *(const f32x4*)(xin + off + 4); }
            }
#pragma unroll
            for (int m = 0; m < 4; ++m) {
                const int row = row0 + ai * HALF + m * 16; float sq = 0.f;
#pragma unroll
                for (int bj = 0; bj < 2; ++bj) {
                    const size_t off = (size_t)row * D + col0 + bj * HALF;
                    f32x4 x0, x1;
                    if (IN_F32) { x0 = xv[m][bj][0]; x1 = xv[m][bj][1]; }
                    else { const u32x4 h = xh[m][bj]; x0 = (f32x4){bflo(h.x), bfhi(h.x), bflo(h.y), bfhi(h.y)}; x1 = (f32x4){bflo(h.z), bfhi(h.z), bflo(h.w), bfhi(h.w)}; }
                    const f32x4 a = x0 + acc[ai][bj][m][0] * alpha, b = x1 + acc[ai][bj][m][1] * alpha;
                    if (OUT_F32) { *(f32x4*)(xout + off) = a; *(f32x4*)(xout + off + 4) = b; }
                    sq += (a.x * a.x + a.y * a.y) + (a.z * a.z + a.w * a.w) + (b.x * b.x + b.y * b.y) + (b.z * b.z + b.w * b.w);
                    if (!OUT_F32) { u32x4 w; w.x = pk(a.x, a.y); w.y = pk(a.z, a.w); w.z = pk(b.x, b.y); w.w = pk(b.z, b.w); *(u32x4*)(xb + off) = w; }
                }
                if (!OUT_F32) { sq += __shfl_xor(sq, 16); sq += __shfl_xor(sq, 32);
                    if (fq == 0) P[(ai * HALF + wr * 64 + m * 16 + fr) * 4 + wc] = sq; }
            }
            asm volatile("" ::: "memory");
        }
        LBAR();
        if (!OUT_F32 && threadIdx.x < 256) { const f32x4 p = *(const LAS f32x4*)(P + threadIdx.x * 4); ssout[(size_t)(u.pm * BM + threadIdx.x) * 4 + u.pn] = (p.x + p.y) + (p.z + p.w); }
    }
};
struct EpiProj {
    static constexpr bool USE_RT = true, AFTER_DRAIN = false;
    bf16_t* O; int ldc; const float* ss;
    __device__ __forceinline__ void operator()(const Acc& acc, const Unit& u, int wr, int wc, int fr, int fq, const RowTab& T) const {
        const int row0 = u.pm * BM + wr * 64 + fr, col0 = u.pn * BM + wc * 32 + 8 * fq;
#pragma unroll
        for (int ai = 0; ai < 2; ++ai)
#pragma unroll
            for (int m = 0; m < 4; ++m) {
                const int row = row0 + ai * HALF + m * 16; const float r = rs_get(T, ss, u, ai * HALF + wr * 64 + m * 16 + fr);
#pragma unroll
                for (int bj = 0; bj < 2; ++bj) {
                    const f32x4 a = acc[ai][bj][m][0] * r, b = acc[ai][bj][m][1] * r;
                    u32x4 w; w.x = pk(a.x, a.y); w.y = pk(a.z, a.w); w.z = pk(b.x, b.y); w.w = pk(b.z, b.w);
                    *(u32x4*)(O + (size_t)row * ldc + col0 + bj * HALF) = w;
                }
            }
    }
};
struct EpiHeadNorm {
    static constexpr bool USE_RT = true, AFTER_DRAIN = false;
    bf16_t* O; int ldc; const float* ss; const float* gain0; const float* gain1; LAS float* P; size_t gxo;
    __device__ __forceinline__ void operator()(const Acc& acc, const Unit& u, int wr, int wc, int fr, int fq, const RowTab& T) const {
        const int row0 = u.pm * BM + wr * 64 + fr, col0 = u.pn * BM + wc * 32 + 8 * fq;
        const bool normed = ((u.pn >> 2) & 1) == 0; const float* gain = (u.pn >= 8) ? gain1 : gain0;
        float rs[2][4];
#pragma unroll
        for (int ai = 0; ai < 2; ++ai)
#pragma unroll
            for (int m = 0; m < 4; ++m) {
                const float r = rs_get(T, ss, u, ai * HALF + wr * 64 + m * 16 + fr); rs[ai][m] = r; float sq = 0.f;
#pragma unroll
                for (int bj = 0; bj < 2; ++bj)
#pragma unroll
                    for (int n = 0; n < 2; ++n) { const f32x4 v = acc[ai][bj][m][n] * r; sq += (v.x * v.x + v.y * v.y) + (v.z * v.z + v.w * v.w); }
                sq += __shfl_xor(sq, 16); sq += __shfl_xor(sq, 32);
                if (fq == 0) P[(ai * HALF + wr * 64 + m * 16 + fr) * 4 + wc] = sq;
            }
        LBAR();
        f32x4 g[2][2];
#pragma unroll
        for (int bj = 0; bj < 2; ++bj)
#pragma unroll
            for (int n = 0; n < 2; ++n) g[bj][n] = normed ? *(const f32x4*)(gain + bj * HALF + wc * 32 + 8 * fq + 4 * n) : (f32x4){1.f, 1.f, 1.f, 1.f};
#pragma unroll
        for (int ai = 0; ai < 2; ++ai)
#pragma unroll
            for (int m = 0; m < 4; ++m) {
                const int rl = ai * HALF + wr * 64 + m * 16 + fr; const f32x4 p = *(const LAS f32x4*)(P + rl * 4);
                const float tot = (p.x + p.y) + (p.z + p.w); const float rn = rs[ai][m] * (normed ? __builtin_amdgcn_rsqf(tot * (1.f / 256.f) + EPS) : 1.f);
                const int row = row0 + ai * HALF + m * 16;
#pragma unroll
                for (int bj = 0; bj < 2; ++bj) {
                    const f32x4 a = acc[ai][bj][m][0] * rn * g[bj][0], b = acc[ai][bj][m][1] * rn * g[bj][1];
                    u32x4 w; w.x = pk(a.x, a.y); w.y = pk(a.z, a.w); w.z = pk(b.x, b.y); w.w = pk(b.z, b.w);
                    *(u32x4*)(O + (size_t)row * ldc + (size_t)(u.pm >> 3) * gxo + col0 + bj * HALF) = w;
                }
            }
    }
};

template <class Epi>
__device__ __forceinline__ void gemm_phase(LAS unsigned char* lds, const Gemm g, const StaticOrder& S, const Epi& E) {
    int tid = threadIdx.x; asm volatile("" : "+v"(tid));
    const int wid = __builtin_amdgcn_readfirstlane(tid >> 6), lane = tid & 63, wr = wid >> 2, wc = wid & 3, fr = lane & 15, fq = lane >> 4;
    const int K = g.K, nt = K / BK;
    unsigned voffA[2], voffB[2];
#pragma unroll
    for (int i = 0; i < 2; ++i) { int R, C; stage_rc(tid * 16 + i * 8192, R, C); const int Rb = (R & ~31) + perm32(R & 31);
        voffA[i] = (unsigned)(R * K + C) * 2u; voffB[i] = (unsigned)(Rb * K + C) * 2u; }
    const size_t kstep = (size_t)(BK * 2);
    const size_t hstep = (size_t)HALF * K * 2;
    const size_t tstep = 2 * hstep;
    const unsigned ldsw = (unsigned)wid * 1024u;
    const int aoff = lds_byte(wr * 64 + fr, fq * 8), boff = lds_byte(wc * 32 + fr, fq * 8);
#define PG8_SA(b, h) (((b) * 2 + (h)) * HTB)
#define PG8_SB(b, h) ((4 + (b) * 2 + (h)) * HTB)
#define PG8_STAGE(bufoff, gbase, voff) do { _Pragma("unroll") for (int _i = 0; _i < 2; ++_i) \
        __builtin_amdgcn_global_load_lds((const unsigned*)((const char*)(gbase) + (voff)[_i]), (LAS unsigned*)(lds + (bufoff) + ldsw + _i * 8192), 16, 0, 0); } while (0)
#define PG8_LDA(dst, b, h) do { _Pragma("unroll") for (int m = 0; m < 4; ++m) _Pragma("unroll") for (int k = 0; k < 2; ++k) dst[m][k] = *(const LAS bf16x8*)(lds + PG8_SA(b, h) + aoff + m * 2048 + k * 1024); } while (0)
#define PG8_LDB(dst, b, h) do { _Pragma("unroll") for (int n = 0; n < 2; ++n) _Pragma("unroll") for (int k = 0; k < 2; ++k) dst[n][k] = *(const LAS bf16x8*)(lds + PG8_SB(b, h) + boff + n * 2048 + k * 1024); } while (0)
#define PG8_MMA(ai, bj, At, Bt) do { __builtin_amdgcn_s_setprio(1); _Pragma("unroll") for (int m = 0; m < 4; ++m) _Pragma("unroll") for (int n = 0; n < 2; ++n) _Pragma("unroll") for (int k = 0; k < 2; ++k) \
        acc[ai][bj][m][n] = __builtin_amdgcn_mfma_f32_16x16x32_bf16(Bt[n][k], At[m][k], acc[ai][bj][m][n], 0, 0, 0); __builtin_amdgcn_s_setprio(0); } while (0)
#define PG8_WAIT_V(n) asm volatile("s_waitcnt vmcnt(" #n ")" ::: "memory")
#define PG8_WAIT_L(n) asm volatile("s_waitcnt lgkmcnt(" #n ")" ::: "memory")
#define PG8_BAR __builtin_amdgcn_s_barrier()
#define PG8_SCHED __builtin_amdgcn_sched_barrier(0)
    Unit cur, nxt; int ui = 0;
    if (!S.next(0, cur)) return;
    RowTab T; T.rt = (const LAS float*)(lds + RT_OFF); T.base_pm = (cur.pm >> 3) << 3;
    f32x4 rtv[4];
    if constexpr (Epi::USE_RT) {
#pragma unroll
        for (int j = 0; j < 4; ++j) { const int row = T.base_pm * BM + tid + 512 * j; rtv[j] = (row < g.M) ? *(const f32x4*)(E.ss + (size_t)row * 4) : (f32x4){1.f, 1.f, 1.f, 1.f}; }
    }
    Acc acc;
#pragma unroll
    for (int a = 0; a < 2; ++a)
#pragma unroll
        for (int b = 0; b < 2; ++b)
#pragma unroll
            for (int m = 0; m < 4; ++m)
#pragma unroll
                for (int n = 0; n < 2; ++n) acc[a][b][m][n] = (f32x4){0.f, 0.f, 0.f, 0.f};
    bf16x8 At[4][2], B0[2][2], B1[2][2];
    const char* cA = (const char*)g.A + (size_t)cur.pm * tstep + (size_t)(cur.pm >> 3) * g.gx; const char* cB = (const char*)g.Bt + (size_t)cur.pn * tstep;
    PG8_STAGE(PG8_SB(0, 0), cB, voffB); PG8_STAGE(PG8_SB(0, 1), cB + hstep, voffB); PG8_STAGE(PG8_SA(0, 0), cA, voffA); PG8_STAGE(PG8_SA(0, 1), cA + hstep, voffA);
    if constexpr (Epi::USE_RT) {
        LAS float* rtw = (LAS float*)(lds + RT_OFF);
#pragma unroll
        for (int j = 0; j < 4; ++j) rtw[tid + 512 * j] = __builtin_amdgcn_rsqf(((rtv[j].x + rtv[j].y) + (rtv[j].z + rtv[j].w)) * (1.f / 1024.f) + EPS);
        asm volatile("s_waitcnt lgkmcnt(0)" ::: "memory");
    }
    if (wr == 1) PG8_BAR;
    PG8_WAIT_V(2); PG8_BAR;
    PG8_STAGE(PG8_SB(1, 0), cB + kstep, voffB); PG8_STAGE(PG8_SA(1, 0), cA + kstep, voffA); PG8_STAGE(PG8_SB(1, 1), cB + hstep + kstep, voffB);
    PG8_WAIT_V(6); PG8_BAR;
    for (;;) {
        const bool has_next = S.next(ui + 1, nxt);
        const char* nA = has_next ? (const char*)g.A + (size_t)nxt.pm * tstep + (size_t)(nxt.pm >> 3) * g.gx : cA; const char* nB = has_next ? (const char*)g.Bt + (size_t)nxt.pn * tstep : cB;
        for (int t = 0; t < nt; t += 2) {
            const bool last = (t == nt - 2);
            const char* a1 = cA + (size_t)(t + 1) * kstep;
            const char* a2 = last ? nA : cA + (size_t)(t + 2) * kstep; const char* b2 = last ? nB : cB + (size_t)(t + 2) * kstep;
            const char* a3 = a2 + kstep; const char* b3 = b2 + kstep;
            PG8_LDB(B0, 0, 0); PG8_LDB(B1, 0, 1); PG8_SCHED; PG8_LDA(At, 0, 0); PG8_STAGE(PG8_SA(1, 1), a1 + hstep, voffA);
            PG8_WAIT_V(8); PG8_WAIT_L(0); PG8_BAR; PG8_MMA(0, 0, At, B0); PG8_MMA(0, 1, At, B1); PG8_BAR; PG8_SCHED;
            PG8_LDA(At, 0, 1); PG8_STAGE(PG8_SB(0, 0), b2, voffB); PG8_STAGE(PG8_SB(0, 1), b2 + hstep, voffB); PG8_STAGE(PG8_SA(0, 0), a2, voffA);
            PG8_WAIT_V(8); PG8_WAIT_L(0); PG8_BAR; PG8_MMA(1, 0, At, B0); PG8_MMA(1, 1, At, B1); PG8_BAR; PG8_SCHED;
            PG8_LDB(B0, 1, 0); PG8_LDB(B1, 1, 1); PG8_SCHED; PG8_LDA(At, 1, 0); PG8_STAGE(PG8_SA(0, 1), a2 + hstep, voffA);
            PG8_WAIT_V(8); PG8_WAIT_L(0); PG8_BAR; PG8_MMA(0, 0, At, B0); PG8_MMA(0, 1, At, B1); PG8_BAR; PG8_SCHED;
            PG8_LDA(At, 1, 1); PG8_STAGE(PG8_SB(1, 0), b3, voffB); PG8_STAGE(PG8_SB(1, 1), b3 + hstep, voffB); PG8_STAGE(PG8_SA(1, 0), a3, voffA);
            PG8_WAIT_V(8); PG8_WAIT_L(0); PG8_BAR; PG8_MMA(1, 0, At, B0); PG8_MMA(1, 1, At, B1); PG8_BAR; PG8_SCHED;
        }
        if (wr == 0) PG8_BAR;
        if constexpr (!Epi::AFTER_DRAIN) E(acc, cur, wr, wc, fr, fq, T);
        if (!has_next) break;
#pragma unroll
        for (int a = 0; a < 2; ++a)
#pragma unroll
            for (int b = 0; b < 2; ++b)
#pragma unroll
                for (int m = 0; m < 4; ++m)
#pragma unroll
                    for (int n = 0; n < 2; ++n) acc[a][b][m][n] = (f32x4){0.f, 0.f, 0.f, 0.f};
        cur = nxt; cA = nA; cB = nB; ++ui;
        if (wr == 1) PG8_BAR;
    }
    PG8_WAIT_V(0);
    PG8_BAR;
    if constexpr (Epi::AFTER_DRAIN) E(acc, cur, wr, wc, fr, fq, T);
#undef PG8_SA
#undef PG8_SB
#undef PG8_STAGE
#undef PG8_LDA
#undef PG8_LDB
#undef PG8_MMA
#undef PG8_WAIT_V
#undef PG8_WAIT_L
#undef PG8_BAR
#undef PG8_SCHED
}
}

struct Args { const float* in[25]; float* out; unsigned char* ws; int ph_lo, ph_hi, use_group, pad; };

struct Ctx {
    LAS unsigned char* lds; int tid, lane, wave, G, blk;
};

__device__ __forceinline__ void tr_item(const float* W, int ldw, const float* g, int K, bf16_t* dst, int k0, int n0, int drow0, LAS float* scr, int lane) {
    { f32x4 v[8]; const int c4 = (lane & 7) * 4;
#pragma unroll
      for (int i = 0; i < 8; ++i) { const int kk = (lane >> 3) + 8 * i; v[i] = *(const f32x4*)(W + (size_t)(k0 + kk) * ldw + n0 + c4); }
#pragma unroll
      for (int i = 0; i < 8; ++i) { const int kk = (lane >> 3) + 8 * i; f32x4 t = v[i]; if (g) t = t * g[k0 + kk];
          LAS float* d = scr + kk * 33 + c4; d[0] = t.x; d[1] = t.y; d[2] = t.z; d[3] = t.w; } }
    LDS_WAIT(); asm volatile("" ::: "memory");
    const int c = lane & 7;
#pragma unroll
    for (int j = 0; j < 4; ++j) { const int n = (lane >> 3) + 8 * j; const LAS float* s = scr + (8 * c) * 33 + n;
        u32x4 o; o.x = pk(s[0 * 33], s[1 * 33]); o.y = pk(s[2 * 33], s[3 * 33]); o.z = pk(s[4 * 33], s[5 * 33]); o.w = pk(s[6 * 33], s[7 * 33]);
        *(u32x4*)(dst + (size_t)(drow0 + n) * K + k0 + 8 * c) = o; }
    LDS_WAIT(); asm volatile("" ::: "memory");
}
__device__ __forceinline__ void tr_plain(const float* W, int ldw, const float* g, int K, int N, bf16_t* dst, int drow_off, int item, LAS float* scr, int lane) {
    const int nnb = N / 32, kb = item / nnb, nb = item % nnb; tr_item(W, ldw, g, K, dst, kb * 64, nb * 32, drow_off + nb * 32, scr, lane);
}
__device__ __forceinline__ void tr_gu(const float* W, const float* g, bf16_t* dst, int upoff, int item, LAS float* scr, int lane) {
    const int nnb = FF / 32, kb = item / nnb, nb = item % nnb, n0 = nb * 32; tr_item(W, FF, g, D, dst, kb * 64, n0, (n0 >> 7) * 256 + (n0 & 127) + upoff, scr, lane);
}
__device__ __forceinline__ void conv_phase(const Ctx& C, const Args& a, int l) {
    LAS float* scr = (LAS float*)(C.lds + C.wave * 16384);
    unsigned char* ws = a.ws;
    const int gw = C.blk * 8 + C.wave, NGW = C.G * 8, lane = C.lane;
    constexpr int I_GU = 16 * 88, I_DN = 44 * 32, I_IN = 16 * 112, I_SQ = 16 * 32;
    const int n_layer = 6 * I_GU + I_IN + 3 * I_SQ;
    const int n_items = n_layer + (l == 0 ? 4 * I_SQ : 0);
    for (int it = gw; it < n_items; it += NGW) {
        int r = it;
        if (r < I_GU) { tr_gu(a.in[3] + (size_t)l * D * FF, a.in[2] + l * D, (bf16_t*)(ws + W_GU1), 0, r, scr, lane); continue; } r -= I_GU;
        if (r < I_GU) { tr_gu(a.in[4] + (size_t)l * D * FF, a.in[2] + l * D, (bf16_t*)(ws + W_GU1), 128, r, scr, lane); continue; } r -= I_GU;
        if (r < I_DN) { tr_plain(a.in[5] + (size_t)l * FF * D, D, nullptr, FF, D, (bf16_t*)(ws + W_D1), 0, r, scr, lane); continue; } r -= I_DN;
        if (r < I_GU) { tr_gu(a.in[22] + (size_t)l * D * FF, a.in[21] + l * D, (bf16_t*)(ws + W_GU2), 0, r, scr, lane); continue; } r -= I_GU;
        if (r < I_GU) { tr_gu(a.in[23] + (size_t)l * D * FF, a.in[21] + l * D, (bf16_t*)(ws + W_GU2), 128, r, scr, lane); continue; } r -= I_GU;
        if (r < I_DN) { tr_plain(a.in[24] + (size_t)l * FF * D, D, nullptr, FF, D, (bf16_t*)(ws + W_D2), 0, r, scr, lane); continue; } r -= I_DN;
        if (r < I_IN) { tr_plain(a.in[7] + (size_t)l * D * NIN, NIN, a.in[6] + l * D, D, NINP, (bf16_t*)(ws + W_IN), 0, r, scr, lane); continue; } r -= I_IN;
        if (r < I_SQ) { tr_plain(a.in[12] + (size_t)l * D * D, D, nullptr, D, D, (bf16_t*)(ws + W_OUT), 0, r, scr, lane); continue; } r -= I_SQ;
        if (r < I_SQ) { tr_plain(a.in[15] + (size_t)l * D * D, D, a.in[13] + l * D, D, D, (bf16_t*)(ws + W_XQ), 0, r, scr, lane); continue; } r -= I_SQ;
        if (r < I_SQ) { tr_plain(a.in[20] + (size_t)l * D * D, D, nullptr, D, D, (bf16_t*)(ws + W_XO), 0, r, scr, lane); continue; } r -= I_SQ;
        { const int which = r / I_SQ, rr = r % I_SQ, ll = which >> 1, kv = which & 1;
          tr_plain(a.in[kv ? 17 : 16] + (size_t)ll * D * D, D, a.in[14] + ll * D, D, D, (bf16_t*)(ws + WS_WKV), ll * 2048 + kv * 1024, rr, scr, lane); }
    }
    if (l == 0) {
        float* ss0 = (float*)(ws + WS_SS); float* ssm = (float*)(ws + WS_SSM);
        for (int m0 = gw; m0 < M + MM; m0 += 2 * NGW) {
            f32x4 v[2][4]; float sq[2];
#pragma unroll
            for (int u = 0; u < 2; ++u) { const int m = m0 + u * NGW; if (m < M + MM) { const bool isx = m < M; const int row = isx ? m : m - M;
                const f32x4* xr = (const f32x4*)((isx ? a.in[0] : a.in[1]) + (size_t)row * D) + lane;
#pragma unroll
                for (int j = 0; j < 4; ++j) v[u][j] = xr[64 * j]; } }
#pragma unroll
            for (int u = 0; u < 2; ++u) { const int m = m0 + u * NGW; if (m < M + MM) { const bool isx = m < M; const int row = isx ? m : m - M;
                bf16_t* dst = (bf16_t*)(ws + (isx ? WS_XB : WS_MEMB)) + (size_t)row * D; float s = 0.f;
#pragma unroll
                for (int j = 0; j < 4; ++j) s += (v[u][j].x * v[u][j].x + v[u][j].y * v[u][j].y) + (v[u][j].z * v[u][j].z + v[u][j].w * v[u][j].w);
                s = wave_sum(s); sq[u] = s;
#pragma unroll
                for (int j = 0; j < 4; ++j) { u32x2 w; w.x = pk(v[u][j].x, v[u][j].y); w.y = pk(v[u][j].z, v[u][j].w); *((u32x2*)dst + lane + 64 * j) = w; }
                if (lane < 4) (isx ? ss0 : ssm)[(size_t)row * 4 + lane] = (lane == 0) ? sq[u] : 0.f; } }
        }
        bf16_t* wgb = (bf16_t*)(ws + WS_WGB);
        for (int idx = C.blk * 512 + C.tid; idx < 2 * 16 * 512; idx += C.G * 512) {
            const int ll = idx >> 13, j = (idx >> 9) & 15, k = (idx & 511) * 2;
            float w0 = 0.f, w1 = 0.f;
            if (j < 8) { w0 = a.in[6][ll * D + k] * a.in[7][(size_t)ll * D * NIN + (size_t)k * NIN + NINP + j]; w1 = a.in[6][ll * D + k + 1] * a.in[7][(size_t)ll * D * NIN + (size_t)(k + 1) * NIN + NINP + j]; }
            ((unsigned*)wgb)[idx] = pk(w0, w1);
        }
        if (C.blk == 0 && C.tid < 64) ((unsigned*)(ws + WS_CTL))[C.tid * 64] = 0u;
    }
}

__device__ __forceinline__ void gates_pass(const Ctx& C, const Args& a, int l, const float* ss) {
    const int hb = C.G / 2;
    if (C.blk < hb) return;
    unsigned char* ws = a.ws;
    const bf16_t* xbp = (const bf16_t*)(ws + WS_XB); const bf16_t* wgb = (const bf16_t*)(ws + WS_WGB) + (size_t)l * 16 * 1024;
    float* gi = (float*)(ws + WS_GI); float* gf = (float*)(ws + WS_GF);
    const float* bg = a.in[8] + l * 8;
    const int lane = C.lane, fr = lane & 15, fq = lane >> 4;
    const bool grp = a.use_group != 0;
    const int gw = grp ? (((C.blk - hb) >> 3) * 8 + C.wave) : ((C.blk - hb) * 8 + C.wave), NGW = grp ? ((((C.G - hb) + 7) >> 3) * 8) : ((C.G - hb) * 8);
    const int tbase = grp ? (C.blk & 7) * (SEQ / 16) : 0, tend = grp ? tbase + SEQ / 16 : M / 16;
    for (int task = tbase + gw; task < tend; task += NGW) {
        const int row0 = task * 16;
        const bf16_t* ap = xbp + (size_t)(row0 + fr) * D + 8 * fq; const bf16_t* bp = wgb + fr * 1024 + 8 * fq;
        f32x4 acc = (f32x4){0.f, 0.f, 0.f, 0.f};
#pragma unroll 8
        for (int kk = 0; kk < 32; ++kk) acc = mfma16(*(const bf16x8*)(ap + 32 * kk), *(const bf16x8*)(bp + 32 * kk), acc);
        if (fr < 8) {
            const int r0 = row0 + 4 * fq, b = r0 >> 11, s = r0 & 2047, h = fr & 3; const float bias = bg[fr];
            f32x4 o;
#pragma unroll
            for (int e = 0; e < 4; ++e) { const float pre = acc[e] * rowscale(ss, r0 + e) + bias; o[e] = (fr < 4) ? pre : fminf(pre, 0.f) - flog(1.f + fexp(-fabsf(pre))); }
            *(f32x4*)((fr < 4 ? gi : gf) + (size_t)(b * 4 + h) * SEQ + s) = o;
        }
    }
}

constexpr int SB_KS = 72;
constexpr int SB_BUF = 2 * 64 * SB_KS * 2;
template <bool MASKED>
__device__ __forceinline__ void sb_tile(const LAS bf16_t* Ks, const LAS bf16_t* Vs, int k0, int tq, int fr, int fq, const bf16x8 (&qf)[2],
                                        const bf16x8 UA, const bf16x8 UB, const bf16x8 ONES, f32x4 (&oacc)[4], float& carry) {
    f32x4 z[4];
#pragma unroll
    for (int i = 0; i < 4; ++i) {
        z[i] = (f32x4){0.f, 0.f, 0.f, 0.f};
#pragma unroll
        for (int kk = 0; kk < 2; ++kk) { const bf16x8 kf = *(const LAS bf16x8*)(Ks + (16 * i + fr) * SB_KS + 32 * kk + 8 * fq); z[i] = mfma16(kf, qf[kk], z[i]); }
    }
    float Lv[4][4], zl[4][4];
    const int lim = tq - k0 - 4 * fq;
#pragma unroll
    for (int i = 0; i < 4; ++i)
#pragma unroll
        for (int e = 0; e < 4; ++e) {
            float zz = z[i][e] * 0.18033688011112042f;
            if (MASKED) zz = (16 * i + e < lim) ? zz : -1e30f;
            const float sp = fmaxf(zz, 0.f) + __builtin_amdgcn_logf(1.f + __builtin_amdgcn_exp2f(-fabsf(zz)));
            Lv[i][e] = -sp; zl[i][e] = zz - sp;
        }
    bf16x8 hi[2];
#pragma unroll
    for (int kk = 0; kk < 2; ++kk) hi[kk] = mk8u(pk(Lv[2 * kk][0], Lv[2 * kk][1]), pk(Lv[2 * kk][2], Lv[2 * kk][3]), pk(Lv[2 * kk + 1][0], Lv[2 * kk + 1][1]), pk(Lv[2 * kk + 1][2], Lv[2 * kk + 1][3]));
    f32x4 tot = (f32x4){0.f, 0.f, 0.f, 0.f};
#pragma unroll
    for (int kk = 0; kk < 2; ++kk) tot = mfma16(ONES, hi[kk], tot);
    unsigned pw[2][4];
#pragma unroll
    for (int io = 0; io < 4; ++io) {
        f32x4 lt = (f32x4){carry, carry, carry, carry};
        { const bf16x8 ud = (io & 1) ? UB : UA; lt = mfma16(ud, hi[io >> 1], lt); }
        if (io < 2) lt = mfma16(ONES, hi[1], lt);
        float av[4];
#pragma unroll
        for (int e = 0; e < 4; ++e) av[e] = __builtin_amdgcn_exp2f(zl[io][e] + lt[e]);
        pw[io >> 1][(io & 1) * 2 + 0] = pk(av[0], av[1]); pw[io >> 1][(io & 1) * 2 + 1] = pk(av[2], av[3]);
    }
    const bf16x8 P0 = mk8u(pw[0][0], pw[0][1], pw[0][2], pw[0][3]), P1 = mk8u(pw[1][0], pw[1][1], pw[1][2], pw[1][3]);
#pragma unroll
    for (int dt = 0; dt < 4; ++dt) {
        const LAS bf16_t* vr = Vs + (4 * fq + (fr >> 2)) * SB_KS + 16 * dt + 4 * (fr & 3);
        const bf16x8 v0 = mk8(trd(vr), trd(vr + 16 * SB_KS)), v1 = mk8(trd(vr + 32 * SB_KS), trd(vr + 48 * SB_KS));
        oacc[dt] = mfma16(v0, P0, oacc[dt]); oacc[dt] = mfma16(v1, P1, oacc[dt]);
    }
    carry += tot[0];
}
__device__ __forceinline__ void sb_unit(const Ctx& C, const bf16_t* proj, bf16_t* mixo, int b, int h, int qb) {
    const int tid = C.tid, lane = C.lane, wid = C.wave, fr = lane & 15, fq = lane >> 4;
    const int q0 = qb * 128, tq = q0 + wid * 16 + fr;
    const size_t rowbase = (size_t)b * SEQ;
    bf16x8 qf[2];
    { const bf16_t* qp = proj + (rowbase + tq) * NINP + h * 64 + 8 * fq; qf[0] = *(const bf16x8*)qp; qf[1] = *(const bf16x8*)(qp + 32); }
    unsigned dg0, dg1;
    { const int d = fr - 4 * fq; dg0 = (0 > d ? 0x3F80u : 0u) | (1 > d ? 0x3F800000u : 0u); dg1 = (2 > d ? 0x3F80u : 0u) | (3 > d ? 0x3F800000u : 0u); }
    const bf16x8 UA = mk8u(dg0, dg1, 0x3F803F80u, 0x3F803F80u), UB = mk8u(0u, 0u, dg0, dg1);
    const bf16x8 ONES = mk8u(0x3F803F80u, 0x3F803F80u, 0x3F803F80u, 0x3F803F80u);
    f32x4 oacc[4];
#pragma unroll
    for (int i = 0; i < 4; ++i) oacc[i] = (f32x4){0.f, 0.f, 0.f, 0.f};
    float carry = 0.f;
    const int jt_max = 2 * qb + 1;
    const int ss_ = tid >> 3, sc_ = tid & 7;
    const bf16_t* kvp = proj + (rowbase + ss_) * NINP + h * 64 + 8 * sc_;
    u32x4 kreg, vreg;
    { const bf16_t* p = kvp + (size_t)(jt_max * 64) * NINP; kreg = *(const u32x4*)(p + 512); vreg = *(const u32x4*)(p + 1024); }
    int cur = 0;
    volatile LAS int* dflag = (volatile LAS int*)(C.lds + MISC_OFF) + 16;
    if (lane == 0) { dflag[wid] = 0; dflag[8 + wid] = 0; }
    int par = 0;
    for (int jt = jt_max; jt >= 0; --jt) {
        LAS unsigned char* buf = C.lds + cur * SB_BUF;
        LAS bf16_t* Ks = (LAS bf16_t*)buf; LAS bf16_t* Vs = (LAS bf16_t*)(buf + 64 * SB_KS * 2);
        *(LAS u32x4*)(Ks + ss_ * SB_KS + 8 * sc_) = kreg;
        *(LAS u32x4*)(Vs + ss_ * SB_KS + 8 * sc_) = vreg;
        if (jt > 0) { const bf16_t* p = kvp + (size_t)((jt - 1) * 64) * NINP; kreg = *(const u32x4*)(p + 512); vreg = *(const u32x4*)(p + 1024); }
        LBAR();
        { const int f = dflag[(par ^ 1) * 8 + (lane & 7)];
          if (__builtin_amdgcn_readfirstlane(__builtin_popcountll(__ballot(f != 0))) == 64) break; }
        const int k0 = jt * 64;
        if (k0 < q0 + wid * 16 + 15 && __ballot(carry < -160.f) != ~0ull) {
            if (k0 + 63 >= q0 + wid * 16) sb_tile<true>(Ks, Vs, k0, tq, fr, fq, qf, UA, UB, ONES, oacc, carry);
            else sb_tile<false>(Ks, Vs, k0, tq, fr, fq, qf, UA, UB, ONES, oacc, carry);
        }
        { const bool dead = __ballot(carry < -160.f) == ~0ull; if (lane == 0) dflag[par * 8 + wid] = dead ? 1 : 0; }
        cur ^= 1; par ^= 1;
    }
    bf16_t* op = mixo + (rowbase + tq) * D + h * 64 + 4 * fq;
#pragma unroll
    for (int dt = 0; dt < 4; ++dt) { u32x2 w; w.x = pk(oacc[dt][0], oacc[dt][1]); w.y = pk(oacc[dt][2], oacc[dt][3]); *(u32x2*)(op + 16 * dt) = w; }
    LBAR();
}

constexpr int ML_QS = 136, ML_VS = 152, ML_CTS = 136;
constexpr int ML_Q = 0, ML_K = ML_Q + 64 * ML_QS * 2, ML_V = ML_K + 64 * ML_QS * 2, ML_CT = ML_V + 64 * ML_VS * 2,
              ML_VEC = ML_CT + 144 * ML_CTS * 2, ML_EX = ML_VEC + 8 * 64 * 4, ML_CW = ML_EX + 2 * 64 * 4, ML_END = ML_CW + 10 * 128 * 4;
static_assert(ML_END <= RING_BYTES, "mlstm LDS");
constexpr int ML_SLOT = 144 * 128 * 2;
__device__ __forceinline__ unsigned char* ml_slot(float* dout, int item) { return (unsigned char*)dout + (size_t)item * ML_SLOT; }
template <int MODE>
__device__ __forceinline__ void mlstm_item(const Ctx& C, const Args& a, int l, int item) {
    const int tid = C.tid, lane = C.lane, wid = C.wave, fr = lane & 15, fq = lane >> 4;
    const int b = item >> 7, h = (item >> 5) & 3, c = item & 31;
    unsigned char* ws = a.ws;
    const bf16_t* proj = (const bf16_t*)(ws + WS_BIG); bf16_t* mixo = (bf16_t*)(ws + WS_MIXO);
    const float* gi = (const float*)(ws + WS_GI) + (size_t)(b * 4 + h) * SEQ; const float* gf = (const float*)(ws + WS_GF) + (size_t)(b * 4 + h) * SEQ;
    float* mlA = (float*)(ws + WS_MLS); float* mlG = mlA + 1024; float* mlM = mlA + 2048;
    LAS bf16_t* Qs = (LAS bf16_t*)(C.lds + ML_Q); LAS bf16_t* Ks = (LAS bf16_t*)(C.lds + ML_K); LAS bf16_t* Vs = (LAS bf16_t*)(C.lds + ML_V); LAS bf16_t* Ct = (LAS bf16_t*)(C.lds + ML_CT);
    LAS float* vec = (LAS float*)(C.lds + ML_VEC);
    LAS float* ex = (LAS float*)(C.lds + ML_EX); LAS float* cw = (LAS float*)(C.lds + ML_CW);
    const size_t rowbase = (size_t)b * SEQ;
    const int dch = tid & 15, rg = tid >> 4;
    const int vs = tid >> 3, vc = tid & 7;
    const int tt = wid & 3, half = wid >> 2;
    const float q_scale = 0.08838834764831845f;
    const int s0 = c * 64;
    {
        float cwr[3];
        { const float* wc_ = a.in[9] + (size_t)l * 4 * 1024; const float* bc_ = a.in[10] + (size_t)l * 1024;
#pragma unroll
          for (int k = 0; k < 2; ++k) { const int i = tid + 512 * k; const int which = i >> 9, j = (i >> 7) & 3, d = i & 127; cwr[k] = wc_[j * 1024 + which * 512 + h * 128 + d]; }
          { const int which = (tid >> 7) & 1, d = tid & 127; cwr[2] = bc_[which * 512 + h * 128 + d]; } }
        u32x4 cst[5];
        if (MODE == 1) { const u32x4* src = (const u32x4*)ml_slot(a.out, item);
#pragma unroll
            for (int k = 0; k < 5; ++k) { const int i = tid + 512 * k; cst[k] = (i < 144 * 16) ? src[i] : (u32x4){0u, 0u, 0u, 0u}; } }
        u32x4 ur[2][5];
#pragma unroll
        for (int which = (MODE == 0 ? 1 : 0); which < 2; ++which)
#pragma unroll
            for (int i = 0; i < 5; ++i) {
                const int sr = s0 + 2 * rg - 3 + i;
                if (sr >= 0) ur[which][i] = *(const u32x4*)(proj + (rowbase + sr) * NINP + h * 128 + 8 * dch + 1536 + 512 * which);
                else ur[which][i] = (u32x4){0u, 0u, 0u, 0u};
            }
        const bf16_t* vp = proj + (rowbase + s0 + vs) * NINP + 2560 + h * 128 + 16 * vc;
        const u32x4 v0 = *(const u32x4*)vp, v1 = *(const u32x4*)(vp + 8);
        float lf = 0.f, li = 0.f;
        if (wid == 0) { lf = gf[s0 + lane]; li = gi[s0 + lane]; }
        cw[tid] = cwr[0]; cw[tid + 512] = cwr[1]; if (tid < 256) cw[1024 + tid] = cwr[2];
        LBAR();
        if (tid < 128) { unsigned o1 = 0x3F803F80u; asm volatile("" : "+v"(o1));
            const u32x4 one = (u32x4){o1, o1, o1, o1}; *(LAS u32x4*)(Vs + (tid >> 1) * ML_VS + 128 + 8 * (tid & 1)) = one; }
        *(LAS u32x4*)(Vs + vs * ML_VS + 16 * vc) = v0; *(LAS u32x4*)(Vs + vs * ML_VS + 16 * vc + 8) = v1;
        if (MODE == 1) {
#pragma unroll
            for (int k = 0; k < 5; ++k) { const int i = tid + 512 * k; if (i < 144 * 16) { const int e = i >> 4, ch = i & 15; *(LAS u32x4*)(Ct + e * ML_CTS + 8 * ch) = cst[k]; } } }
#pragma unroll
        for (int which = (MODE == 0 ? 1 : 0); which < 2; ++which) {
#pragma unroll
            for (int rr = 0; rr < 2; ++rr) {
                f32x4 ya = *(const LAS f32x4*)(cw + 1024 + which * 128 + 8 * dch), yb = *(const LAS f32x4*)(cw + 1024 + which * 128 + 8 * dch + 4);
#pragma unroll
                for (int j = 0; j < 4; ++j) {
                    const u32x4 u = ur[which][rr + j];
                    ya = ya + (f32x4){bflo(u.x), bfhi(u.x), bflo(u.y), bfhi(u.y)} * *(const LAS f32x4*)(cw + which * 512 + j * 128 + 8 * dch);
                    yb = yb + (f32x4){bflo(u.z), bfhi(u.z), bflo(u.w), bfhi(u.w)} * *(const LAS f32x4*)(cw + which * 512 + j * 128 + 8 * dch + 4);
                }
                float y[8] = {ya.x, ya.y, ya.z, ya.w, yb.x, yb.y, yb.z, yb.w};
#pragma unroll
                for (int i = 0; i < 8; ++i) { y[i] = y[i] * sigmoidf_(y[i]); if (!which) y[i] *= q_scale; }
                const int r = 2 * rg + rr;
                u32x4 w; w.x = pk(y[0], y[1]); w.y = pk(y[2], y[3]); w.z = pk(y[4], y[5]); w.w = pk(y[6], y[7]);
                *(LAS u32x4*)((which ? Ks : Qs) + r * ML_QS + 8 * dch) = w;
            }
        }
        if (wid == 0) {
            float bc = lf;
#pragma unroll
            for (int o = 1; o < 64; o <<= 1) { const float t = __shfl_up(bc, o); if (lane >= o) bc += t; }
            const float ct = li - bc; float pm = ct;
#pragma unroll
            for (int o = 1; o < 64; o <<= 1) { const float t = __shfl_up(pm, o); if (lane >= o) pm = fmaxf(pm, t); }
            const float b63 = __shfl(bc, 63);
            if (MODE == 0) {
                const float a_c = b63 + __shfl(pm, 63);
                vec[256 + lane] = fexp(b63 + ct - a_c);
                if (lane == 0) { mlA[item] = a_c; mlG[item] = b63; }
            } else {
                const float m_st = mlM[item];
                const float mt = bc + fmaxf(pm, m_st);
                vec[lane] = bc; vec[64 + lane] = ct; vec[128 + lane] = mt; vec[192 + lane] = fexp(bc + m_st - mt); vec[320 + lane] = fexp(-mt);
            }
        }
    }
    LBAR();
    if (MODE == 1) {
        const int t = 16 * tt + fr;
        bf16x8 qfr[4];
#pragma unroll
        for (int kk = 0; kk < 4; ++kk) qfr[kk] = *(const LAS bf16x8*)(Qs + t * ML_QS + 32 * kk + 8 * fq);
        const float rowterm = vec[t] - vec[128 + t], winter = vec[192 + t], einv = vec[320 + t];
        unsigned pw[2][4];
#pragma unroll
        for (int i = 0; i < 4; ++i) {
            f32x4 sa = (f32x4){0.f, 0.f, 0.f, 0.f};
#pragma unroll
            for (int kk = 0; kk < 4; ++kk) { const bf16x8 kf = *(const LAS bf16x8*)(Ks + (16 * i + fr) * ML_QS + 32 * kk + 8 * fq); sa = mfma16(kf, qfr[kk], sa); }
            const f32x4 ctv = *(const LAS f32x4*)(vec + 64 + 16 * i + 4 * fq);
            float sc[4];
#pragma unroll
            for (int e = 0; e < 4; ++e) { const int s = 16 * i + 4 * fq + e; sc[e] = (s <= t) ? sa[e] * fexp(rowterm + ctv[e]) : 0.f; }
            pw[i >> 1][(i & 1) * 2 + 0] = pk(sc[0], sc[1]); pw[i >> 1][(i & 1) * 2 + 1] = pk(sc[2], sc[3]);
        }
        const bf16x8 P0 = mk8u(pw[0][0], pw[0][1], pw[0][2], pw[0][3]), P1 = mk8u(pw[1][0], pw[1][1], pw[1][2], pw[1][3]);
        f32x4 num[5];
#pragma unroll
        for (int ei = 0; ei < 5; ++ei) {
            const int et = (ei == 4) ? 8 : 4 * half + ei;
            const LAS bf16_t* vr = Vs + (4 * fq + (fr >> 2)) * ML_VS + 16 * et + 4 * (fr & 3);
            const bf16x8 v0 = mk8(trd(vr), trd(vr + 16 * ML_VS)), v1 = mk8(trd(vr + 32 * ML_VS), trd(vr + 48 * ML_VS));
            f32x4 intra = (f32x4){0.f, 0.f, 0.f, 0.f}; intra = mfma16(v0, P0, intra); intra = mfma16(v1, P1, intra);
            f32x4 inter = (f32x4){0.f, 0.f, 0.f, 0.f};
#pragma unroll
            for (int kk = 0; kk < 4; ++kk) { const bf16x8 cf = *(const LAS bf16x8*)(Ct + (16 * et + fr) * ML_CTS + 32 * kk + 8 * fq); inter = mfma16(cf, qfr[kk], inter); }
            num[ei] = intra + inter * winter;
        }
        const float den = fmaxf(fabsf(num[4][0]), einv); const float dinv = 1.f / den;
        float sq = 0.f;
#pragma unroll
        for (int ei = 0; ei < 4; ++ei) { num[ei] = num[ei] * dinv; sq += (num[ei][0] * num[ei][0] + num[ei][1] * num[ei][1]) + (num[ei][2] * num[ei][2] + num[ei][3] * num[ei][3]); }
        sq += __shfl_xor(sq, 16); sq += __shfl_xor(sq, 32);
        if (fq == 0) ex[half * 64 + t] = sq;
        LBAR();
        const float tot = ex[t] + ex[64 + t]; const float rn = __builtin_amdgcn_rsqf(tot * (1.f / 128.f) + EPS);
        const float* gh = a.in[11] + (size_t)l * 512 + h * 128;
        const bf16_t* og = proj + (rowbase + s0 + t) * NINP + 3072 + h * 128;
        bf16_t* op = mixo + (rowbase + s0 + t) * D + 512 + h * 128;
#pragma unroll
        for (int ei = 0; ei < 4; ++ei) {
            const int e0 = 16 * (4 * half + ei) + 4 * fq;
            const f32x4 g4 = *(const f32x4*)(gh + e0); const u32x2 o2 = *(const u32x2*)(og + e0);
            const float y0 = num[ei][0] * rn * g4.x * sigmoidf_(bflo(o2.x)), y1 = num[ei][1] * rn * g4.y * sigmoidf_(bfhi(o2.x));
            const float y2 = num[ei][2] * rn * g4.z * sigmoidf_(bflo(o2.y)), y3 = num[ei][3] * rn * g4.w * sigmoidf_(bfhi(o2.y));
            u32x2 w; w.x = pk(y0, y1); w.y = pk(y2, y3); *(u32x2*)(op + e0) = w;
        }
    }
    if (MODE == 0) {
        bf16x8 kw[2];
#pragma unroll
        for (int kk = 0; kk < 2; ++kk) {
            const LAS bf16_t* kr = Ks + (32 * kk + 8 * fq + (fr >> 2)) * ML_QS + 16 * wid + 4 * (fr & 3);
            const u32x2 k0 = trd(kr), k1 = trd(kr + 4 * ML_QS);
            const f32x4 w0 = *(const LAS f32x4*)(vec + 256 + 32 * kk + 8 * fq), w1 = *(const LAS f32x4*)(vec + 256 + 32 * kk + 8 * fq + 4);
            kw[kk] = mk8u(pk(bflo(k0.x) * w0.x, bfhi(k0.x) * w0.y), pk(bflo(k0.y) * w0.z, bfhi(k0.y) * w0.w),
                          pk(bflo(k1.x) * w1.x, bfhi(k1.x) * w1.y), pk(bflo(k1.y) * w1.z, bfhi(k1.y) * w1.w));
        }
        bf16_t* slot = (bf16_t*)ml_slot(a.out, item);
#pragma unroll
        for (int et = 0; et < 9; ++et) {
            f32x4 cacc = (f32x4){0.f, 0.f, 0.f, 0.f};
#pragma unroll
            for (int kk = 0; kk < 2; ++kk) {
                const LAS bf16_t* vr = Vs + (32 * kk + 8 * fq + (fr >> 2)) * ML_VS + 16 * et + 4 * (fr & 3);
                const bf16x8 vf = mk8(trd(vr), trd(vr + 4 * ML_VS));
                cacc = mfma16(kw[kk], vf, cacc);
            }
            u32x2 w; w.x = pk(cacc[0], cacc[1]); w.y = pk(cacc[2], cacc[3]);
            *(u32x2*)(slot + (size_t)(16 * et + fr) * 128 + 16 * wid + 4 * fq) = w;
        }
    }
    LBAR();
}

__device__ __forceinline__ void mlstm_scan(const Ctx& C, const Args& a) {
    unsigned char* ws = a.ws;
    const float* mlA = (const float*)(ws + WS_MLS); const float* mlG = mlA + 1024; float* mlM = (float*)(ws + WS_MLS) + 2048;
    for (int w = C.blk; w < 256; w += C.G) {
        const int bh = w >> 3, slice = w & 7;
        if (C.tid < 384) {
            const int widx = slice * 1152 + C.tid;
            float st[6] = {0.f, 0.f, 0.f, 0.f, 0.f, 0.f}; float m = 0.f;
            unsigned sw[32][3];
#pragma unroll
            for (int cc = 0; cc < 32; ++cc) { const unsigned* sp = (const unsigned*)ml_slot(a.out, bh * 32 + cc) + widx;
#pragma unroll
                for (int j = 0; j < 3; ++j) sw[cc][j] = sp[384 * j]; }
#pragma unroll
            for (int cc = 0; cc < 32; ++cc) {
                const int item = bh * 32 + cc;
                const float a_c = mlA[item], g_c = mlG[item];
                const float m_new = fmaxf(g_c + m, a_c), al = fexp(g_c + m - m_new), be = fexp(a_c - m_new);
                unsigned* dp = (unsigned*)ml_slot(a.out, item) + widx;
#pragma unroll
                for (int j = 0; j < 3; ++j) {
                    dp[384 * j] = pk(st[2 * j], st[2 * j + 1]);
                    st[2 * j] = al * st[2 * j] + be * bflo(sw[cc][j]); st[2 * j + 1] = al * st[2 * j + 1] + be * bfhi(sw[cc][j]);
                }
                if (slice == 0 && C.tid == 0) mlM[item] = m;
                m = m_new;
            }
        }
    }
}

constexpr int XA_KS = 264;
constexpr int XA_BUF = 64 * XA_KS * 2;
template <bool QL = false>
__device__ __forceinline__ void xattn_unit(const Ctx& C, const bf16_t* qn, const bf16_t* kv, bf16_t* obuf, int l, int b, int h, int qb, const LAS bf16_t* qlds = nullptr, int kvoff = 0) {
    const int tid = C.tid, lane = C.lane, wid = C.wave, fr = lane & 15, fq = lane >> 4;
    const int t = qb * 128 + wid * 16 + fr;
    const size_t qrow = (size_t)b * SEQ + t;
    bf16x8 qf[8];
    if (QL) { const LAS bf16_t* qp = qlds + (wid * 16 + fr) * XA_KS + 8 * fq;
#pragma unroll
      for (int kk = 0; kk < 8; ++kk) qf[kk] = *(const LAS bf16x8*)(qp + 32 * kk); }
    else { const bf16_t* qp = qn + qrow * D + (size_t)b * (GX_Q / 2) + h * 256 + 8 * fq;
#pragma unroll
      for (int kk = 0; kk < 8; ++kk) qf[kk] = *(const bf16x8*)(qp + 32 * kk); }
    const int ss_ = tid >> 3, sc_ = tid & 7;
    const bf16_t* kbase = kv + ((size_t)b * MEML + ss_) * 4096 + l * 2048 + h * 256 + 8 * sc_;
#define XA_SRC(s_) (((s_) < 4) ? kbase + (size_t)(64 * (s_)) * 4096 : kbase + 1024 + (size_t)(64 * ((s_) - 4)) * 4096)
    u32x4 st[2][4];
#pragma unroll
    for (int i = 0; i < 4; ++i) { st[0][i] = *(const u32x4*)(XA_SRC(0) + 64 * i); st[1][i] = *(const u32x4*)(XA_SRC(1) + 64 * i); }
    f32x4 S[16];
    int cur = 0;
#pragma unroll
    for (int c = 0; c < 4; ++c) {
        LAS bf16_t* Kc = (LAS bf16_t*)(C.lds + kvoff + cur * XA_BUF);
#pragma unroll
        for (int i = 0; i < 4; ++i) *(LAS u32x4*)(Kc + ss_ * XA_KS + 8 * sc_ + 64 * i) = st[c & 1][i];
        { const bf16_t* nb = XA_SRC(c + 2);
#pragma unroll
          for (int i = 0; i < 4; ++i) st[c & 1][i] = *(const u32x4*)(nb + 64 * i); }
        LBAR();
#pragma unroll
        for (int i = 0; i < 4; ++i) {
            f32x4 sa = (f32x4){0.f, 0.f, 0.f, 0.f};
#pragma unroll
            for (int kk = 0; kk < 8; ++kk) { const bf16x8 kf = *(const LAS bf16x8*)(Kc + (16 * i + fr) * XA_KS + 32 * kk + 8 * fq); sa = mfma16(kf, qf[kk], sa); }
            S[4 * c + i] = sa;
        }
        cur ^= 1;
    }
    float mx = -1e30f;
#pragma unroll
    for (int i = 0; i < 16; ++i) mx = fmaxf(mx, fmaxf(fmaxf(S[i][0], S[i][1]), fmaxf(S[i][2], S[i][3])));
    mx = fmaxf(mx, __shfl_xor(mx, 16)); mx = fmaxf(mx, __shfl_xor(mx, 32));
    float sum = 0.f;
#pragma unroll
    for (int i = 0; i < 16; ++i)
#pragma unroll
        for (int e = 0; e < 4; ++e) { const float p = fexp((S[i][e] - mx) * 0.0625f); S[i][e] = p; sum += p; }
    sum += __shfl_xor(sum, 16); sum += __shfl_xor(sum, 32);
    bf16x8 pf[8];
#pragma unroll
    for (int k2 = 0; k2 < 8; ++k2) pf[k2] = mk8u(pk(S[2 * k2][0], S[2 * k2][1]), pk(S[2 * k2][2], S[2 * k2][3]), pk(S[2 * k2 + 1][0], S[2 * k2 + 1][1]), pk(S[2 * k2 + 1][2], S[2 * k2 + 1][3]));
    f32x4 O[16];
#pragma unroll
    for (int i = 0; i < 16; ++i) O[i] = (f32x4){0.f, 0.f, 0.f, 0.f};
#pragma unroll
    for (int c = 0; c < 4; ++c) {
        LAS bf16_t* Vc = (LAS bf16_t*)(C.lds + kvoff + cur * XA_BUF);
#pragma unroll
        for (int i = 0; i < 4; ++i) *(LAS u32x4*)(Vc + ss_ * XA_KS + 8 * sc_ + 64 * i) = st[c & 1][i];
        if (c < 2) { const bf16_t* nb = XA_SRC(c + 6);
#pragma unroll
            for (int i = 0; i < 4; ++i) st[c & 1][i] = *(const u32x4*)(nb + 64 * i); }
        LBAR();
#pragma unroll
        for (int dt = 0; dt < 16; ++dt) {
            const LAS bf16_t* vr = Vc + (4 * fq + (fr >> 2)) * XA_KS + 16 * dt + 4 * (fr & 3);
            const bf16x8 v0 = mk8(trd(vr), trd(vr + 16 * XA_KS)), v1 = mk8(trd(vr + 32 * XA_KS), trd(vr + 48 * XA_KS));
            O[dt] = mfma16(v0, pf[2 * c], O[dt]); O[dt] = mfma16(v1, pf[2 * c + 1], O[dt]);
        }
        cur ^= 1;
    }
    const float inv = 1.f / sum;
    bf16_t* op = obuf + qrow * D + (size_t)b * (GX_Q / 2) + h * 256 + 4 * fq;
#pragma unroll
    for (int dt = 0; dt < 16; ++dt) { u32x2 w; w.x = pk(O[dt][0] * inv, O[dt][1] * inv); w.y = pk(O[dt][2] * inv, O[dt][3] * inv); *(u32x2*)(op + 16 * dt) = w; }
    LBAR();
}

struct EpiQXattn {
    static constexpr bool USE_RT = true, AFTER_DRAIN = true;
    const float* ss; const float* gain; LAS float* P; LAS unsigned char* lds; const bf16_t* kv; bf16_t* obuf; int l;
    __device__ __forceinline__ void operator()(const pg8::Acc& acc, const pg8::Unit& u, int wr, int wc, int fr, int fq, const pg8::RowTab& T) const {
        using namespace pg8;
        float rn[2][4];
#pragma unroll
        for (int ai = 0; ai < 2; ++ai)
#pragma unroll
            for (int m = 0; m < 4; ++m) {
                const float r = rs_get(T, ss, u, ai * HALF + wr * 64 + m * 16 + fr); rn[ai][m] = r; float sq = 0.f;
#pragma unroll
                for (int bj = 0; bj < 2; ++bj)
#pragma unroll
                    for (int n = 0; n < 2; ++n) { const f32x4 v = acc[ai][bj][m][n] * r; sq += (v.x * v.x + v.y * v.y) + (v.z * v.z + v.w * v.w); }
                sq += __shfl_xor(sq, 16); sq += __shfl_xor(sq, 32);
                if (fq == 0) P[(ai * HALF + wr * 64 + m * 16 + fr) * 4 + wc] = sq;
            }
        LBAR();
        f32x4 g[2][2];
#pragma unroll
        for (int bj = 0; bj < 2; ++bj)
#pragma unroll
            for (int n = 0; n < 2; ++n) g[bj][n] = *(const f32x4*)(gain + bj * HALF + wc * 32 + 8 * fq + 4 * n);
#pragma unroll
        for (int ai = 0; ai < 2; ++ai)
#pragma unroll
            for (int m = 0; m < 4; ++m) { const f32x4 p = *(const LAS f32x4*)(P + (ai * HALF + wr * 64 + m * 16 + fr) * 4);
                rn[ai][m] *= __builtin_amdgcn_rsqf(((p.x + p.y) + (p.z + p.w)) * (1.f / 256.f) + EPS); }
        Ctx C2; { int t_ = threadIdx.x; asm volatile("" : "+v"(t_)); C2.tid = t_; C2.lane = t_ & 63; C2.wave = __builtin_amdgcn_readfirstlane(t_ >> 6); } C2.lds = lds; C2.G = gridDim.x; C2.blk = blockIdx.x;
        LAS bf16_t* Qs = (LAS bf16_t*)lds;
        const int b = u.pm >> 3, h = u.pn;
        u32x4 qw[2][4][2];
#pragma unroll
        for (int hf = 0; hf < 2; ++hf)
#pragma unroll
            for (int m = 0; m < 4; ++m)
#pragma unroll
                for (int bj = 0; bj < 2; ++bj) {
                    const f32x4 a = acc[hf][bj][m][0] * rn[hf][m] * g[bj][0], c = acc[hf][bj][m][1] * rn[hf][m] * g[bj][1];
                    u32x4 w; w.x = pk(a.x, a.y); w.y = pk(a.z, a.w); w.z = pk(c.x, c.y); w.w = pk(c.z, c.w); qw[hf][m][bj] = w;
                }
#pragma unroll
        for (int hf = 0; hf < 2; ++hf) {
            LBAR();
#pragma unroll
            for (int m = 0; m < 4; ++m)
#pragma unroll
                for (int bj = 0; bj < 2; ++bj) *(LAS u32x4*)(Qs + (wr * 64 + m * 16 + fr) * XA_KS + bj * HALF + wc * 32 + 8 * fq) = qw[hf][m][bj];
            LBAR();
            xattn_unit<true>(C2, nullptr, kv, obuf, l, b, h, (u.pm & 7) * 2 + hf, Qs, 128 * XA_KS * 2);
        }
    }
};
static_assert(128 * XA_KS * 2 + 2 * XA_BUF <= MISC_OFF, "query tile + K/V chunk buffers below the LDS control words");

#define XB_TMO      128
#define XB_XCNT(j)  (256  + 64 * (j))
#define XB_XSUB(j)  (1280 + 64 * (j))
#define XB_XGEN(j)  (2304 + 64 * (j))
#define XB_TOP      3328
#define XB_TOPGEN   3392
#define XCD_BAR_WORDS 3456
#define XB_SPIN_CAP (1u << 22)
constexpr int CW_BAR = 4096;
constexpr size_t CTL_ZERO_BYTES = 64 * 1024;
__device__ __forceinline__ unsigned xb_ld(unsigned* p)              { return __hip_atomic_load(p, __ATOMIC_RELAXED, __HIP_MEMORY_SCOPE_AGENT); }
__device__ __forceinline__ unsigned xb_add(unsigned* p, unsigned v) { return __hip_atomic_fetch_add(p, v, __ATOMIC_RELAXED, __HIP_MEMORY_SCOPE_AGENT); }
__device__ __forceinline__ unsigned xb_xcc_id() { return (unsigned)__builtin_amdgcn_s_getreg((3 << 11) | 20) & 0xFu; }
#define XB_SPIN(cond, bar) do { unsigned _sp = 0; while (cond) { __builtin_amdgcn_s_sleep(1); \
    if ((++_sp & 255u) == 0u) { if (xb_ld(&(bar)[XB_TMO])) break; if (_sp > XB_SPIN_CAP) { atomicAdd(&(bar)[XB_TMO], 1u); break; } } } } while (0)
struct XcdBarrier { unsigned* bar; unsigned x; volatile LAS unsigned* st; };
__device__ __forceinline__ XcdBarrier xcd_barrier_post(unsigned* bar, volatile LAS unsigned* st) {
    XcdBarrier b; b.bar = bar; b.x = xb_xcc_id(); b.st = st;
    if (threadIdx.x == 0) (void)xb_add(&bar[XB_XCNT(b.x)], 1u);
    return b;
}
__device__ __forceinline__ void xcd_barrier_complete(unsigned* bar, unsigned x, unsigned& nloc, unsigned& nx) {
    const unsigned G = gridDim.x * gridDim.y * gridDim.z;
    unsigned sum, cnt, mine, sp = 0u;
    for (;;) {
        sum = 0u; cnt = 0u; mine = 0u;
#pragma unroll
        for (unsigned j = 0; j < 16; ++j) { const unsigned c = xb_ld(&bar[XB_XCNT(j)]); sum += c; cnt += (c > 0u) ? 1u : 0u; mine = (j == x) ? c : mine; }
        if (sum == G) break;
        __builtin_amdgcn_s_sleep(1);
        if ((++sp & 255u) == 0u) { if (xb_ld(&bar[XB_TMO])) break; if (sp > XB_SPIN_CAP) { atomicAdd(&bar[XB_TMO], 1u); break; } }
    }
    nloc = mine > 0u ? mine : 1u; nx = cnt > 0u ? cnt : 1u;
}
__device__ __forceinline__ void xcd_barrier(const XcdBarrier& b) {
    asm volatile("s_waitcnt vmcnt(0)" ::: "memory");
    __syncthreads();
    if (threadIdx.x == 0) {
        unsigned* bar = b.bar;
        __builtin_amdgcn_s_waitcnt(0);
        unsigned nloc = b.st[0], nx = b.st[1];
        if (nloc == 0u) { xcd_barrier_complete(bar, b.x, nloc, nx); b.st[0] = nloc; b.st[1] = nx; }
        const unsigned old = xb_add(&bar[XB_XSUB(b.x)], 1u);
        const unsigned gen = old / nloc;
        if (old + 1u == (gen + 1u) * nloc) {
            __builtin_amdgcn_fence(__ATOMIC_RELEASE, "agent");
            asm volatile("s_waitcnt vmcnt(0)" ::: "memory");
            const unsigned og = xb_add(&bar[XB_TOP], 1u);
            const unsigned tg = og / nx;
            if (og + 1u == (tg + 1u) * nx) xb_add(&bar[XB_TOPGEN], 1u);
            else XB_SPIN(xb_ld(&bar[XB_TOPGEN]) == tg, bar);
            __builtin_amdgcn_fence(__ATOMIC_ACQUIRE, "agent");
            xb_add(&bar[XB_XGEN(b.x)], 1u);
            asm volatile("s_waitcnt vmcnt(0)" ::: "memory");
        } else {
            XB_SPIN(xb_ld(&bar[XB_XGEN(b.x)]) == gen, bar);
            __builtin_amdgcn_fence(__ATOMIC_ACQUIRE, "agent");
            asm volatile("s_waitcnt vmcnt(0)" ::: "memory");
        }
    }
    __syncthreads();
}

constexpr int CW_GRP = 8192, CW_GMASK = 12288;
template <bool HEAVY>
__device__ __forceinline__ void group_barrier(unsigned* gctr, unsigned target) {
    asm volatile("s_waitcnt vmcnt(0)" ::: "memory");
    __syncthreads();
    if (threadIdx.x == 0) {
        if (HEAVY) { __builtin_amdgcn_fence(__ATOMIC_RELEASE, "agent"); asm volatile("s_waitcnt vmcnt(0)" ::: "memory"); }
        (void)xb_add(gctr, 1u);
        unsigned sp = 0u;
        while (xb_ld(gctr) < target) { __builtin_amdgcn_s_sleep(1); if (++sp > XB_SPIN_CAP) break; }
        __builtin_amdgcn_fence(__ATOMIC_ACQUIRE, "agent");
        asm volatile("s_waitcnt vmcnt(0)" ::: "memory");
    }
    __syncthreads();
}

__global__ void __launch_bounds__(512, 2) fwd_kernel(Args a) {
    extern __shared__ __attribute__((aligned(16))) unsigned char lds_raw[];
    Ctx C; C.lds = (LAS unsigned char*)lds_raw; C.G = gridDim.x; C.blk = blockIdx.x;
    unsigned char* ws = a.ws;
    const int lo = a.ph_lo, hi = a.ph_hi;
#define xb ((bf16_t*)(a.ws + WS_XB))
#define big ((bf16_t*)(a.ws + WS_BIG))
#define mixo ((bf16_t*)(a.ws + WS_MIXO))
#define qn big
#define ob (big + (size_t)(4 * MiB / 2))
#define ssb0 ((float*)(a.ws + WS_SS))
#define ssb1 (ssb0 + (size_t)M * 4)
    LAS float* P = (LAS float*)(C.lds + XSCR_OFF);
    volatile LAS int* misc = (volatile LAS int*)(C.lds + MISC_OFF);
    XcdBarrier xbar; xbar.bar = nullptr; xbar.x = 0; xbar.st = nullptr;
    if (hi - lo > 1) {
        if (threadIdx.x < 2) misc[8 + threadIdx.x] = 0;
        __syncthreads();
        xbar = xcd_barrier_post((unsigned*)(ws + WS_CTL) + CW_BAR, (volatile LAS unsigned*)(misc + 8));
    }
#ifndef PROBE_DUP_LO
#define PROBE_DUP_LO 0
#define PROBE_DUP_N 0
#endif
    unsigned gk = 0u; const unsigned gmembers = (unsigned)((C.G - (C.blk & 7) + 7) / 8);
    int glocal = -1;
    if (a.use_group && hi - lo > 1 && threadIdx.x == 0) __hip_atomic_fetch_or((unsigned*)(ws + WS_CTL) + CW_GMASK + (C.blk & 7), 1u << xb_xcc_id(), __ATOMIC_RELAXED, __HIP_MEMORY_SCOPE_AGENT);
    for (int it = lo; it < hi; ++it) {
        const int rep = (PROBE_DUP_N > 0 && it >= PROBE_DUP_LO + PROBE_DUP_N && it < PROBE_DUP_LO + 2 * PROBE_DUP_N) ? 1 : 0;
        const int ph = (PROBE_DUP_N > 0 && it >= PROBE_DUP_LO + PROBE_DUP_N) ? it - PROBE_DUP_N : it;
        const int l = ph / 13, p = ph % 13;
#define RELAUNDER() do { int t_ = threadIdx.x; asm volatile("" : "+v"(t_)); C.tid = t_; C.lane = t_ & 63; C.wave = __builtin_amdgcn_readfirstlane(t_ >> 6); } while (0)
        RELAUNDER();
        if (p == 0) conv_phase(C, a, l);
        else if (p == 1 || p == 11) {
            pg8::Gemm g{xb, (const bf16_t*)(ws + (p == 1 ? W_GU1 : W_GU2)), M, NGU, D}; pg8::StaticOrder S; S.init(M, NGU, C.G, C.blk);
            pg8::EpiSwiglu E{big, p == 1 ? ssb0 : ssb1};
            pg8::gemm_phase(C.lds, g, S, E);
            if (ph == 1 && rep == 0) {
                pg8::Gemm g2{(const bf16_t*)(ws + WS_MEMB), (const bf16_t*)(ws + WS_WKV), MM, 4096, D}; pg8::StaticOrder S2; S2.init(MM, 4096, C.G, (C.blk + C.G / 2) % C.G);
                pg8::EpiHeadNorm E2{(bf16_t*)(ws + WS_KV), 4096, (const float*)(ws + WS_SSM), a.in[19], a.in[19] + 256, P, 0};
                pg8::gemm_phase(C.lds, g2, S2, E2);
            }
        } else if (p == 2 || p == 12) {
            pg8::Gemm g{big, (const bf16_t*)(ws + (p == 2 ? W_D1 : W_D2)), M, D, FF, GX_H}; pg8::StaticOrder S; S.init(M, D, C.G, C.blk);
            if (ph == 2) { pg8::EpiResid<true, false> E{a.in[0], a.out, xb, ssb1, 0.5f, P}; pg8::gemm_phase(C.lds, g, S, E); }
            else if (ph == NPH - 1) { pg8::EpiResid<false, true> E{a.in[0], a.out, xb, ssb0, 0.5f, P}; pg8::gemm_phase(C.lds, g, S, E); }
            else { pg8::EpiResid<false, false> E{a.in[0], a.out, xb, p == 2 ? ssb1 : ssb0, 0.5f, P}; pg8::gemm_phase(C.lds, g, S, E); }
        } else if (p == 3) {
            pg8::Gemm g{xb, (const bf16_t*)(ws + W_IN), M, NINP, D}; pg8::StaticOrder S; S.init(M, NINP, C.G, C.blk);
            pg8::EpiProj E{big, NINP, ssb1};
            pg8::gemm_phase(C.lds, g, S, E);
            RELAUNDER();
            gates_pass(C, a, l, ssb1);
        } else if (p == 4 || p == 6) {
            unsigned* ctr = (unsigned*)(ws + WS_CTL) + 64 * (2 * l + (p == 6 ? 1 : 0) + 4 * rep);
            if (C.tid == 0) misc[0] = (int)atomicAdd(ctr, 1u);
            LBAR();
            int idx = misc[0];
            LBAR();
            while (idx < 1536) {
                unsigned nxt = 0u;
                if (C.tid == 0) nxt = atomicAdd(ctr, 1u);
                if (idx < 1024) { if (p == 4) mlstm_item<0>(C, a, l, idx); else mlstm_item<1>(C, a, l, idx); }
                else { const int u2 = 2 * (idx - 1024) + (p == 6 ? 1 : 0); const int qb = 15 - (u2 >> 6), bh = u2 & 63; sb_unit(C, big, mixo, bh >> 3, bh & 7, qb); }
                if (C.tid == 0) misc[0] = (int)nxt;
                LBAR();
                idx = misc[0];
                LBAR();
            }
        } else if (p == 5) {
            mlstm_scan(C, a);
        } else if (p == 7) {
            pg8::Gemm g{mixo, (const bf16_t*)(ws + W_OUT), M, D, D}; pg8::StaticOrder S; S.init(M, D, C.G, C.blk);
            pg8::EpiResid<false, false> E{a.in[0], a.out, xb, ssb0, 1.0f, P};
            pg8::gemm_phase(C.lds, g, S, E);
        } else if (p == 8) {
            pg8::Gemm g{xb, (const bf16_t*)(ws + W_XQ), M, D, D}; pg8::StaticOrder S; S.init(M, D, C.G, C.blk);
            if ((M / 256) * (D / 256) == C.G) {
                EpiQXattn EQ{ssb0, a.in[18] + l * 256, P, C.lds, (const bf16_t*)(ws + WS_KV), ob, l};
                pg8::gemm_phase(C.lds, g, S, EQ);
            } else {
            pg8::EpiHeadNorm E{qn, D, ssb0, a.in[18] + l * 256, a.in[18] + l * 256, P, GX_Q / 2};
            pg8::gemm_phase(C.lds, g, S, E);
            asm volatile("s_waitcnt vmcnt(0)" ::: "memory"); __syncthreads();
            RELAUNDER();
            { pg8::Unit u; for (int i = 0; S.next(i, u); ++i) { const int b = u.pm >> 3, qb0 = (u.pm & 7) * 2;
                xattn_unit(C, qn, (const bf16_t*)(ws + WS_KV), ob, l, b, u.pn, qb0); xattn_unit(C, qn, (const bf16_t*)(ws + WS_KV), ob, l, b, u.pn, qb0 + 1); } }
            }
        } else if (p == 9) {
        } else if (p == 10) {
            pg8::Gemm g{ob, (const bf16_t*)(ws + W_XO), M, D, D, GX_Q}; pg8::StaticOrder S; S.init(M, D, C.G, C.blk);
            pg8::EpiResid<false, false> E{a.in[0], a.out, xb, ssb1, 1.0f, P};
            pg8::gemm_phase(C.lds, g, S, E);
        }
        if (it + 1 < hi && p != 9) {
            if (lo < 0) cg::this_grid().sync();
            const bool grp = a.use_group && (p == 1 || p == 2 || p == 7 || p == 8 || p == 10 || p == 11);
            if (grp) {
                if (glocal < 0) glocal = (__builtin_popcount(xb_ld((unsigned*)(ws + WS_CTL) + CW_GMASK + (C.blk & 7))) == 1) ? 1 : 0;
                ++gk; unsigned* gctr = (unsigned*)(ws + WS_CTL) + CW_GRP + 64 * (C.blk & 7);
                if (glocal) group_barrier<false>(gctr, gk * gmembers); else group_barrier<true>(gctr, gk * gmembers);
            } else xcd_barrier(xbar);
        }
    }
}

#undef xb
#undef big
#undef mixo
#undef qn
#undef ob
#undef ssb0
#undef ssb1
extern "C" void kernel_launch(void* const* d_in, const int* in_sizes, int n_in, void* d_out, int out_size, void* d_ws, size_t ws_size, hipStream_t stream) {
    static int grid = 0;
    if (grid == 0) {
        if (n_in != 25 || out_size != M * D || ws_size < WS_END) { fprintf(stderr, "kernel_launch: unexpected problem (n_in %d out %d ws %zu)\n", n_in, out_size, ws_size); grid = -1; return; }
        int dev = 0, cus = 0, per_cu = 0;
        hipGetDevice(&dev); hipDeviceGetAttribute(&cus, hipDeviceAttributeMultiprocessorCount, dev);
        hipFuncSetAttribute((const void*)fwd_kernel, hipFuncAttributeMaxDynamicSharedMemorySize, LDS_BYTES);
        hipOccupancyMaxActiveBlocksPerMultiprocessor(&per_cu, (const void*)fwd_kernel, 512, LDS_BYTES);
        if (per_cu < 1) per_cu = 1;
        grid = cus * per_cu;
        (void)hipGetLastError();
        { const int shp[4][2] = {{M, NGU}, {M, NINP}, {M, D}, {MM, 4096}}; bool ok = true;
          for (int s = 0; s < 4 && ok; ++s) for (int c = 0; c < grid && ok; ++c) { pg8::StaticOrder S; S.init(shp[s][0], shp[s][1], grid, c); pg8::Unit u; int base = -1;
              for (int i = 0; S.next(i, u); ++i) { if (base < 0) base = (u.pm >> 3) << 3; if (u.pm < base || u.pm >= base + 8) ok = false; } }
          if (!ok) { fprintf(stderr, "kernel_launch: unit order does not keep a workgroup inside one 8-panel group on a %d-workgroup grid; nothing launched\n", grid); grid = -1; return; } }
    }
    if (grid < 0) return;
    if (hipMemsetAsync((char*)d_ws + WS_CTL, 0, CTL_ZERO_BYTES, stream) != hipSuccess) { fprintf(stderr, "kernel_launch: memset failed\n"); return; }
    static int use_group = -1;
    if (use_group < 0) {
        bool ok = (grid % 16 == 0);
        const int shp2[3] = {NGU, NINP, D};
        for (int s2 = 0; s2 < 3 && ok; ++s2) for (int c = 0; c < grid && ok; ++c) { pg8::StaticOrder S; S.init(M, shp2[s2], grid, c); pg8::Unit u;
            for (int i = 0; S.next(i, u); ++i) if ((u.pm >> 3) != (c & 7)) ok = false; }
        use_group = ok ? 1 : 0;
    }
    Args a{};
    a.use_group = use_group;
    for (int i = 0; i < 25; ++i) a.in[i] = (const float*)d_in[i];
    a.out = (float*)d_out; a.ws = (unsigned char*)d_ws;
#if MK_ONE
    a.ph_lo = 0; a.ph_hi = NPH + PROBE_DUP_N;
    void* args[] = {&a};
    hipError_t e = hipLaunchCooperativeKernel((const void*)fwd_kernel, dim3(grid), dim3(512), args, LDS_BYTES, stream);
    if (e != hipSuccess) fprintf(stderr, "cooperative launch failed: %s (grid %d)\n", hipGetErrorString(e), grid);
#else
#ifndef PH_LIMIT
#define PH_LIMIT NPH
#endif
    for (int ph = 0; ph < PH_LIMIT; ++ph) { a.ph_lo = ph; a.ph_hi = ph + 1; hipLaunchKernelGGL(fwd_kernel, dim3(grid), dim3(512), LDS_BYTES, stream, a); }
#endif
}
```

```cpp
#include <hip/hip_runtime.h>
#include <hip/hip_cooperative_groups.h>
#include <cstdio>
#include <cstdint>
namespace cg = cooperative_groups;

#ifndef MK_ONE
#define MK_ONE 1
#endif

#ifndef PH_MASK
#define PH_MASK 0x1ff
#endif
#define PH_ON(k) (((PH_MASK) >> (k)) & 1)
#define LAS __attribute__((address_space(3)))
typedef unsigned short bf16_t;
typedef short bf16x8 __attribute__((ext_vector_type(8)));
typedef float f32x4 __attribute__((ext_vector_type(4)));
typedef unsigned u32x4 __attribute__((ext_vector_type(4)));
typedef unsigned u32x2 __attribute__((ext_vector_type(2)));

constexpr int BATCH = 8, SEQ = 2048, D = 1024, M = BATCH * SEQ, FF = 2816, NGU = 2 * FF, NIN = 3592, NINP = 3584, MEML = 256, MM = BATCH * MEML;
constexpr float EPS = 1e-6f;
constexpr int NPH = 26;

constexpr size_t MiB = 1u << 20;
constexpr size_t WS_CTL = 0;
constexpr size_t WS_SS = 64 * 1024;
constexpr size_t WS_SSM = WS_SS + 2 * MiB;
constexpr size_t WS_GI = WS_SSM + 128 * 1024;
constexpr size_t WS_GF = WS_GI + 256 * 1024;
constexpr size_t WS_WG = WS_GF + 256 * 1024;
constexpr size_t WS_MLS = WS_WG + 64 * 1024;
constexpr size_t WS_WGB = WS_MLS + 16 * 1024;
constexpr size_t WS_W = 3 * MiB;
constexpr size_t W_GU1 = WS_W, W_D1 = W_GU1 + 11 * MiB, W_IN = W_D1 + 5 * MiB + 512 * 1024, W_OUT = W_IN + 7 * MiB, W_XQ = W_OUT + 2 * MiB, W_XO = W_XQ + 2 * MiB,
                 W_GU2 = W_XO + 2 * MiB, W_D2 = W_GU2 + 11 * MiB, W_END = W_D2 + 5 * MiB + 512 * 1024;
constexpr size_t WS_WKV = 49 * MiB;
constexpr size_t WS_XB = 57 * MiB;
constexpr size_t WS_BIG = 89 * MiB;
constexpr size_t GRP_STRIDE = 14 * MiB;
constexpr size_t GX_H = GRP_STRIDE - 2048 * (size_t)FF * 2, GX_Q = GRP_STRIDE - 2048 * (size_t)D * 2;
constexpr size_t WS_MIXO = 201 * MiB;
constexpr size_t WS_KV = 233 * MiB;
constexpr size_t WS_MEMB = 249 * MiB;
constexpr size_t WS_END = 254 * MiB;
static_assert(W_END == 49 * MiB, "weight map");

constexpr int RING_BYTES = 131072;
constexpr int XSCR_OFF = RING_BYTES;
constexpr int MISC_OFF = XSCR_OFF + 4096;
constexpr int RT_OFF = 139264;
constexpr int LDS_BYTES = 147456;

typedef float f32x2_t __attribute__((ext_vector_type(2)));
typedef __bf16 bf16x2_t __attribute__((ext_vector_type(2)));
__device__ __forceinline__ unsigned pk(float lo, float hi) { f32x2_t v = {lo, hi}; bf16x2_t b = __builtin_convertvector(v, bf16x2_t); return __builtin_bit_cast(unsigned, b); }
__device__ __forceinline__ float bflo(unsigned u) { return __uint_as_float(u << 16); }
__device__ __forceinline__ float bfhi(unsigned u) { return __uint_as_float(u & 0xffff0000u); }
__device__ __forceinline__ float fexp(float x) { return __builtin_amdgcn_exp2f(x * 1.4426950408889634f); }
__device__ __forceinline__ float flog(float x) { return __builtin_amdgcn_logf(x) * 0.6931471805599453f; }
__device__ __forceinline__ float frcp(float x) { return __builtin_amdgcn_rcpf(x); }
__device__ __forceinline__ float softplus(float z) { return fmaxf(z, 0.f) + flog(1.f + fexp(-fabsf(z))); }
__device__ __forceinline__ float sigmoidf_(float z) { return frcp(1.f + fexp(-z)); }
__device__ __forceinline__ float wave_sum(float v) {
#pragma unroll
    for (int o = 1; o < 64; o <<= 1) v += __shfl_xor(v, o);
    return v;
}
__device__ __forceinline__ f32x4 mfma16(bf16x8 a, bf16x8 b, f32x4 c) { return __builtin_amdgcn_mfma_f32_16x16x32_bf16(a, b, c, 0, 0, 0); }
__device__ __forceinline__ bf16x8 mk8(u32x2 a, u32x2 b) { u32x4 t; t.x = a.x; t.y = a.y; t.z = b.x; t.w = b.y; return __builtin_bit_cast(bf16x8, t); }
__device__ __forceinline__ bf16x8 mk8u(unsigned a, unsigned b, unsigned c, unsigned d) { u32x4 t; t.x = a; t.y = b; t.z = c; t.w = d; return __builtin_bit_cast(bf16x8, t); }
typedef short v4i16_t __attribute__((ext_vector_type(4)));
__device__ __forceinline__ u32x2 trd(const LAS bf16_t* p) { return __builtin_bit_cast(u32x2, __builtin_amdgcn_ds_read_tr16_b64_v4i16((LAS v4i16_t*)p)); }
__device__ __forceinline__ float rowscale(const float* ss, int row) {
    const f32x4 a = *(const f32x4*)(ss + (size_t)row * 4);
    return __builtin_amdgcn_rsqf(((a.x + a.y) + (a.z + a.w)) * (1.f / 1024.f) + EPS);
}
#define LDS_WAIT() asm volatile("s_waitcnt lgkmcnt(0)" ::: "memory")
#define WG_BAR() do { asm volatile("s_waitcnt vmcnt(0) lgkmcnt(0)" ::: "memory"); __builtin_amdgcn_s_barrier(); asm volatile("" ::: "memory"); } while (0)
#define LBAR() do { asm volatile("s_waitcnt lgkmcnt(0)" ::: "memory"); __builtin_amdgcn_s_barrier(); asm volatile("" ::: "memory"); } while (0)

namespace pg8 {
constexpr int BM = 256, BK = 64, HALF = 128, HTB = HALF * BK * 2, STAGE_BYTES = 8 * HTB, NXCD = 8, WGM = 8;
__host__ __device__ __forceinline__ int lds_byte(int r, int c) { const int st = (r >> 4) * 2 + (c >> 5), rr = r & 15, cc = c & 31, ob = rr * 64 + cc * 2; return st * 1024 + (ob ^ (((ob >> 9) & 1) << 5)); }
__host__ __device__ __forceinline__ void stage_rc(int b, int& R, int& C) { const int st = b / 1024, sb = b % 1024, swz = sb ^ (((sb >> 9) & 1) << 5); R = (st >> 1) * 16 + swz / 64; C = (st & 1) * 32 + (swz % 64) / 2; }
__host__ __device__ __forceinline__ int perm32(int rho) { const int n = rho >> 4, i = rho & 15; return 8 * (i >> 2) + 4 * n + (i & 3); }
struct Unit { int pm, pn; };
struct Gemm { const bf16_t* A; const bf16_t* Bt; int M, N, K; size_t gx = 0; };
struct StaticOrder {
    int nM, nN, nwg, G, c, direct_hb;
    __host__ __device__ void init(int M_, int N_, int G_, int c_) { nM = M_ / BM; nN = N_ / BM; nwg = nM * nN; G = G_; c = c_; direct_hb = -1; }
    __host__ __device__ bool next(int i, Unit& u) const {
        if (direct_hb >= 0) { if (i > 0 || c < direct_hb) return false; u.pm = c & 7; u.pn = (c - direct_hb) >> 3; return u.pn < nN && u.pm < nM; }
        const long L = (long)i * G + c; if (L >= nwg) return false;
        int wgid = (int)L; { const int q = nwg / NXCD, r = nwg % NXCD, xcd = wgid % NXCD, off = wgid / NXCD; wgid = (xcd < r ? xcd * (q + 1) : r * (q + 1) + (xcd - r) * q) + off; }
        const int nig = WGM * nN, gid = wgid / nig, fm = gid * WGM, gsz = (nM - fm) < WGM ? (nM - fm) : WGM;
        u.pm = fm + ((wgid % nig) % gsz); u.pn = (wgid % nig) / gsz; return true;
    }
};
typedef f32x4 Acc[2][2][4][2];

struct RowTab { const LAS float* rt; int base_pm; };
__device__ __forceinline__ float rs_get(const RowTab& T, const float* ss, const Unit& u, int rl) {
    return T.rt[((u.pm - T.base_pm) & 7) * BM + rl];
}
struct EpiSwiglu {
    static constexpr bool USE_RT = true, AFTER_DRAIN = false;
    bf16_t* H; const float* ss;
    __device__ __forceinline__ void operator()(const Acc& acc, const Unit& u, int wr, int wc, int fr, int fq, const RowTab& T) const {
        const int row0 = u.pm * BM + wr * 64 + fr, col0 = u.pn * HALF + wc * 32 + 8 * fq;
#pragma unroll
        for (int ai = 0; ai < 2; ++ai)
#pragma unroll
            for (int m = 0; m < 4; ++m) {
                const int row = row0 + ai * HALF + m * 16; const float r = rs_get(T, ss, u, ai * HALF + wr * 64 + m * 16 + fr);
                const float rs_ = r * -1.4426950408889634f, r2 = r * r;
                float hv[8];
#pragma unroll
                for (int n = 0; n < 2; ++n)
#pragma unroll
                    for (int e = 0; e < 4; ++e) { const float g = acc[ai][0][m][n][e], up = acc[ai][1][m][n][e]; hv[4 * n + e] = (g * up) * (r2 * frcp(1.f + __builtin_amdgcn_exp2f(g * rs_))); }
                u32x4 w; w.x = pk(hv[0], hv[1]); w.y = pk(hv[2], hv[3]); w.z = pk(hv[4], hv[5]); w.w = pk(hv[6], hv[7]);
                *(u32x4*)(H + (size_t)row * FF + (size_t)(u.pm >> 3) * (GX_H / 2) + col0) = w;
            }
    }
};
template <bool IN_F32, bool OUT_F32>
struct EpiResid {
    static constexpr bool USE_RT = false, AFTER_DRAIN = false; static constexpr const float* ss = nullptr;
    const float* xin; float* xout; bf16_t* xb; float* ssout; float alpha; LAS float* P;
    __device__ __forceinline__ void operator()(const Acc& acc, const Unit& u, int wr, int wc, int fr, int fq, const RowTab& T) const {
        const int row0 = u.pm * BM + wr * 64 + fr, col0 = u.pn * BM + wc * 32 + 8 * fq;
#pragma unroll
        for (int ai = 0; ai < 2; ++ai) {
            u32x4 xh[4][2];
            if (!IN_F32) {
#pragma unroll
                for (int m = 0; m < 4; ++m)
#pragma unroll
                    for (int bj = 0; bj < 2; ++bj) xh[m][bj] = *(const u32x4*)(xb + (size_t)(row0 + ai * HALF + m * 16) * D + col0 + bj * HALF);
            }
            f32x4 xv[4][2][2];
            if (IN_F32) {
#pragma unroll
                for (int m = 0; m < 4; ++m)
#pragma unroll
                    for (int bj = 0; bj < 2; ++bj) { const size_t off = (size_t)(row0 + ai * HALF + m * 16) * D + col0 + bj * HALF; xv[m][bj][0] = *(const f32x4*)(xin + off); xv[m][bj][1] = *(const f32x4*)(xin + off + 4); }
            }
#pragma unroll
            for (int m = 0; m < 4; ++m) {
                const int row = row0 + ai * HALF + m * 16; float sq = 0.f;
#pragma unroll
                for (int bj = 0; bj < 2; ++bj) {
                    const size_t off = (size_t)row * D + col0 + bj * HALF;
                    f32x4 x0, x1;
                    if (IN_F32) { x0 = xv[m][bj][0]; x1 = xv[m][bj][1]; }
                    else { const u32x4 h = xh[m][bj]; x0 = (f32x4){bflo(h.x), bfhi(h.x), bflo(h.y), bfhi(h.y)}; x1 = (f32x4){bflo(h.z), bfhi(h.z), bflo(h.w), bfhi(h.w)}; }
                    const f32x4 a = x0 + acc[ai][bj][m][0] * alpha, b = x1 + acc[ai][bj][m][1] * alpha;
                    if (OUT_F32) { *(f32x4*)(xout + off) = a; *(f32x4*)(xout + off + 4) = b; }
                    sq += (a.x * a.x + a.y * a.y) + (a.z * a.z + a.w * a.w) + (b.x * b.x + b.y * b.y) + (b.z * b.z + b.w * b.w);
                    if (!OUT_F32) { u32x4 w; w.x = pk(a.x, a.y); w.y = pk(a.z, a.w); w.z = pk(b.x, b.y); w.w = pk(b.z, b.w); *(u32x4*)(xb + off) = w; }
                }
                if (!OUT_F32) { sq += __shfl_xor(sq, 16); sq += __shfl_xor(sq, 32);
                    if (fq == 0) P[(ai * HALF + wr * 64 + m * 16 + fr) * 4 + wc] = sq; }
            }
            asm volatile("" ::: "memory");
        }
        LBAR();
        if (!OUT_F32 && threadIdx.x < 256) { const f32x4 p = *(const LAS f32x4*)(P + threadIdx.x * 4); ssout[(size_t)(u.pm * BM + threadIdx.x) * 4 + u.pn] = (p.x + p.y) + (p.z + p.w); }
    }
};
struct EpiProj {
    static constexpr bool USE_RT = true, AFTER_DRAIN = false;
    bf16_t* O; int ldc; const float* ss;
    __device__ __forceinline__ void operator()(const Acc& acc, const Unit& u, int wr, int wc, int fr, int fq, const RowTab& T) const {
        const int row0 = u.pm * BM + wr * 64 + fr, col0 = u.pn * BM + wc * 32 + 8 * fq;
#pragma unroll
        for (int ai = 0; ai < 2; ++ai)
#pragma unroll
            for (int m = 0; m < 4; ++m) {
                const int row = row0 + ai * HALF + m * 16; const float r = rs_get(T, ss, u, ai * HALF + wr * 64 + m * 16 + fr);
#pragma unroll
                for (int bj = 0; bj < 2; ++bj) {
                    const f32x4 a = acc[ai][bj][m][0] * r, b = acc[ai][bj][m][1] * r;
                    u32x4 w; w.x = pk(a.x, a.y); w.y = pk(a.z, a.w); w.z = pk(b.x, b.y); w.w = pk(b.z, b.w);
                    *(u32x4*)(O + (size_t)row * ldc + col0 + bj * HALF) = w;
                }
            }
    }
};
struct EpiHeadNorm {
    static constexpr bool USE_RT = true, AFTER_DRAIN = false;
    bf16_t* O; int ldc; const float* ss; const float* gain0; const float* gain1; LAS float* P; size_t gxo;
    __device__ __forceinline__ void operator()(const Acc& acc, const Unit& u, int wr, int wc, int fr, int fq, const RowTab& T) const {
        const int row0 = u.pm * BM + wr * 64 + fr, col0 = u.pn * BM + wc * 32 + 8 * fq;
        const bool normed = ((u.pn >> 2) & 1) == 0; const float* gain = (u.pn >= 8) ? gain1 : gain0;
        float rs[2][4];
#pragma unroll
        for (int ai = 0; ai < 2; ++ai)
#pragma unroll
            for (int m = 0; m < 4; ++m) {
                const float r = rs_get(T, ss, u, ai * HALF + wr * 64 + m * 16 + fr); rs[ai][m] = r; float sq = 0.f;
#pragma unroll
                for (int bj = 0; bj < 2; ++bj)
#pragma unroll
                    for (int n = 0; n < 2; ++n) { const f32x4 v = acc[ai][bj][m][n] * r; sq += (v.x * v.x + v.y * v.y) + (v.z * v.z + v.w * v.w); }
                sq += __shfl_xor(sq, 16); sq += __shfl_xor(sq, 32);
                if (fq == 0) P[(ai * HALF + wr * 64 + m * 16 + fr) * 4 + wc] = sq;
            }
        LBAR();
        f32x4 g[2][2];
#pragma unroll
        for (int bj = 0; bj < 2; ++bj)
#pragma unroll
            for (int n = 0; n < 2; ++n) g[bj][n] = normed ? *(const f32x4*)(gain + bj * HALF + wc * 32 + 8 * fq + 4 * n) : (f32x4){1.f, 1.f, 1.f, 1.f};
#pragma unroll
        for (int ai = 0; ai < 2; ++ai)
#pragma unroll
            for (int m = 0; m < 4; ++m) {
                const int rl = ai * HALF + wr * 64 + m * 16 + fr; const f32x4 p = *(const LAS f32x4*)(P + rl * 4);
                const float tot = (p.x + p.y) + (p.z + p.w); const float rn = rs[ai][m] * (normed ? __builtin_amdgcn_rsqf(tot * (1.f / 256.f) + EPS) : 1.f);
                const int row = row0 + ai * HALF + m * 16;
#pragma unroll
                for (int bj = 0; bj < 2; ++bj) {
                    const f32x4 a = acc[ai][bj][m][0] * rn * g[bj][0], b = acc[ai][bj][m][1] * rn * g[bj][1];
                    u32x4 w; w.x = pk(a.x, a.y); w.y = pk(a.z, a.w); w.z = pk(b.x, b.y); w.w = pk(b.z, b.w);
                    *(u32x4*)(O + (size_t)row * ldc + (size_t)(u.pm >> 3) * gxo + col0 + bj * HALF) = w;
                }
            }
    }
};

template <class Epi>
__device__ __forceinline__ void gemm_phase(LAS unsigned char* lds, const Gemm g, const StaticOrder& S, const Epi& E) {
    int tid = threadIdx.x; asm volatile("" : "+v"(tid));
    const int wid = __builtin_amdgcn_readfirstlane(tid >> 6), lane = tid & 63, wr = wid >> 2, wc = wid & 3, fr = lane & 15, fq = lane >> 4;
    const int K = g.K, nt = K / BK;
    unsigned voffA[2], voffB[2];
#pragma unroll
    for (int i = 0; i < 2; ++i) { int R, C; stage_rc(tid * 16 + i * 8192, R, C); const int Rb = (R & ~31) + perm32(R & 31);
        voffA[i] = (unsigned)(R * K + C) * 2u; voffB[i] = (unsigned)(Rb * K + C) * 2u; }
    const size_t kstep = (size_t)(BK * 2);
    const size_t hstep = (size_t)HALF * K * 2;
    const size_t tstep = 2 * hstep;
    const unsigned ldsw = (unsigned)wid * 1024u;
    const int aoff = lds_byte(wr * 64 + fr, fq * 8), boff = lds_byte(wc * 32 + fr, fq * 8);
#define PG8_SA(b, h) (((b) * 2 + (h)) * HTB)
#define PG8_SB(b, h) ((4 + (b) * 2 + (h)) * HTB)
#define PG8_STAGE(bufoff, gbase, voff) do { _Pragma("unroll") for (int _i = 0; _i < 2; ++_i) \
        __builtin_amdgcn_global_load_lds((const unsigned*)((const char*)(gbase) + (voff)[_i]), (LAS unsigned*)(lds + (bufoff) + ldsw + _i * 8192), 16, 0, 0); } while (0)
#define PG8_LDA(dst, b, h) do { _Pragma("unroll") for (int m = 0; m < 4; ++m) _Pragma("unroll") for (int k = 0; k < 2; ++k) dst[m][k] = *(const LAS bf16x8*)(lds + PG8_SA(b, h) + aoff + m * 2048 + k * 1024); } while (0)
#define PG8_LDB(dst, b, h) do { _Pragma("unroll") for (int n = 0; n < 2; ++n) _Pragma("unroll") for (int k = 0; k < 2; ++k) dst[n][k] = *(const LAS bf16x8*)(lds + PG8_SB(b, h) + boff + n * 2048 + k * 1024); } while (0)
#define PG8_MMA(ai, bj, At, Bt) do { __builtin_amdgcn_s_setprio(1); _Pragma("unroll") for (int m = 0; m < 4; ++m) _Pragma("unroll") for (int n = 0; n < 2; ++n) _Pragma("unroll") for (int k = 0; k < 2; ++k) \
        acc[ai][bj][m][n] = __builtin_amdgcn_mfma_f32_16x16x32_bf16(Bt[n][k], At[m][k], acc[ai][bj][m][n], 0, 0, 0); __builtin_amdgcn_s_setprio(0); } while (0)
#define PG8_WAIT_V(n) asm volatile("s_waitcnt vmcnt(" #n ")" ::: "memory")
#define PG8_WAIT_L(n) asm volatile("s_waitcnt lgkmcnt(" #n ")" ::: "memory")
#define PG8_BAR __builtin_amdgcn_s_barrier()
#define PG8_SCHED __builtin_amdgcn_sched_barrier(0)
    Unit cur, nxt; int ui = 0;
    if (!S.next(0, cur)) return;
    RowTab T; T.rt = (const LAS float*)(lds + RT_OFF); T.base_pm = (cur.pm >> 3) << 3;
    f32x4 rtv[4];
    if constexpr (Epi::USE_RT) {
#pragma unroll
        for (int j = 0; j < 4; ++j) { const int row = T.base_pm * BM + tid + 512 * j; rtv[j] = (row < g.M) ? *(const f32x4*)(E.ss + (size_t)row * 4) : (f32x4){1.f, 1.f, 1.f, 1.f}; }
    }
    Acc acc;
#pragma unroll
    for (int a = 0; a < 2; ++a)
#pragma unroll
        for (int b = 0; b < 2; ++b)
#pragma unroll
            for (int m = 0; m < 4; ++m)
#pragma unroll
                for (int n = 0; n < 2; ++n) acc[a][b][m][n] = (f32x4){0.f, 0.f, 0.f, 0.f};
    bf16x8 At[4][2], B0[2][2], B1[2][2];
    const char* cA = (const char*)g.A + (size_t)cur.pm * tstep + (size_t)(cur.pm >> 3) * g.gx; const char* cB = (const char*)g.Bt + (size_t)cur.pn * tstep;
    PG8_STAGE(PG8_SB(0, 0), cB, voffB); PG8_STAGE(PG8_SB(0, 1), cB + hstep, voffB); PG8_STAGE(PG8_SA(0, 0), cA, voffA); PG8_STAGE(PG8_SA(0, 1), cA + hstep, voffA);
    if constexpr (Epi::USE_RT) {
        LAS float* rtw = (LAS float*)(lds + RT_OFF);
#pragma unroll
        for (int j = 0; j < 4; ++j) rtw[tid + 512 * j] = __builtin_amdgcn_rsqf(((rtv[j].x + rtv[j].y) + (rtv[j].z + rtv[j].w)) * (1.f / 1024.f) + EPS);
        asm volatile("s_waitcnt lgkmcnt(0)" ::: "memory");
    }
    if (wr == 1) PG8_BAR;
    PG8_WAIT_V(2); PG8_BAR;
    PG8_STAGE(PG8_SB(1, 0), cB + kstep, voffB); PG8_STAGE(PG8_SA(1, 0), cA + kstep, voffA); PG8_STAGE(PG8_SB(1, 1), cB + hstep + kstep, voffB);
    PG8_WAIT_V(6); PG8_BAR;
    for (;;) {
        const bool has_next = S.next(ui + 1, nxt);
        const char* nA = has_next ? (const char*)g.A + (size_t)nxt.pm * tstep + (size_t)(nxt.pm >> 3) * g.gx : cA; const char* nB = has_next ? (const char*)g.Bt + (size_t)nxt.pn * tstep : cB;
        for (int t = 0; t < nt; t += 2) {
            const bool last = (t == nt - 2);
            const char* a1 = cA + (size_t)(t + 1) * kstep;
            const char* a2 = last ? nA : cA + (size_t)(t + 2) * kstep; const char* b2 = last ? nB : cB + (size_t)(t + 2) * kstep;
            const char* a3 = a2 + kstep; const char* b3 = b2 + kstep;
            PG8_LDB(B0, 0, 0); PG8_LDB(B1, 0, 1); PG8_SCHED; PG8_LDA(At, 0, 0); PG8_STAGE(PG8_SA(1, 1), a1 + hstep, voffA);
            PG8_WAIT_V(8); PG8_WAIT_L(0); PG8_BAR; PG8_MMA(0, 0, At, B0); PG8_MMA(0, 1, At, B1); PG8_BAR; PG8_SCHED;
            PG8_LDA(At, 0, 1); PG8_STAGE(PG8_SB(0, 0), b2, voffB); PG8_STAGE(PG8_SB(0, 1), b2 + hstep, voffB); PG8_STAGE(PG8_SA(0, 0), a2, voffA);
            PG8_WAIT_V(8); PG8_WAIT_L(0); PG8_BAR; PG8_MMA(1, 0, At, B0); PG8_MMA(1, 1, At, B1); PG8_BAR; PG8_SCHED;
            PG8_LDB(B0, 1, 0); PG8_LDB(B1, 1, 1); PG8_SCHED; PG8_LDA(At, 1, 0); PG8_STAGE(PG8_SA(0, 1), a2 + hstep, voffA);
            PG8_WAIT_V(8); PG8_WAIT_L(0); PG8_BAR; PG8_MMA(0, 0, At, B0); PG8_MMA(0, 1, At, B1); PG8_BAR; PG8_SCHED;
            PG8_LDA(At, 1, 1); PG8_STAGE(PG8_SB(1, 0), b3, voffB); PG8_STAGE(PG8_SB(1, 1), b3 + hstep, voffB); PG8_STAGE(PG8_SA(1, 0), a3, voffA);
            PG8_WAIT_V(8); PG8_WAIT_L(0); PG8_BAR; PG8_MMA(1, 0, At, B0); PG8_MMA(1, 1, At, B1); PG8_BAR; PG8_SCHED;
        }
        if (wr == 0) PG8_BAR;
        if constexpr (!Epi::AFTER_DRAIN) E(acc, cur, wr, wc, fr, fq, T);
        if (!has_next) break;
#pragma unroll
        for (int a = 0; a < 2; ++a)
#pragma unroll
            for (int b = 0; b < 2; ++b)
#pragma unroll
                for (int m = 0; m < 4; ++m)
#pragma unroll
                    for (int n = 0; n < 2; ++n) acc[a][b][m][n] = (f32x4){0.f, 0.f, 0.f, 0.f};
        cur = nxt; cA = nA; cB = nB; ++ui;
        if (wr == 1) PG8_BAR;
    }
    PG8_WAIT_V(0);
    PG8_BAR;
    if constexpr (Epi::AFTER_DRAIN) E(acc, cur, wr, wc, fr, fq, T);
#undef PG8_SA
#undef PG8_SB
#undef PG8_STAGE
#undef PG8_LDA
#undef PG8_LDB
#undef PG8_MMA
#undef PG8_WAIT_V
#undef PG8_WAIT_L
#undef PG8_BAR
#undef PG8_SCHED
}
}

struct Args { const float* in[25]; float* out; unsigned char* ws; int ph_lo, ph_hi, use_group, pad; };

struct Ctx {
    LAS unsigned char* lds; int tid, lane, wave, G, blk;
};

__device__ __forceinline__ void tr_item(const float* W, int ldw, const float* g, int K, bf16_t* dst, int k0, int n0, int drow0, LAS float* scr, int lane) {
    { f32x4 v[8]; const int c4 = (lane & 7) * 4;
#pragma unroll
      for (int i = 0; i < 8; ++i) { const int kk = (lane >> 3) + 8 * i; v[i] = *(const f32x4*)(W + (size_t)(k0 + kk) * ldw + n0 + c4); }
#pragma unroll
      for (int i = 0; i < 8; ++i) { const int kk = (lane >> 3) + 8 * i; f32x4 t = v[i]; if (g) t = t * g[k0 + kk];
          LAS float* d = scr + kk * 33 + c4; d[0] = t.x; d[1] = t.y; d[2] = t.z; d[3] = t.w; } }
    LDS_WAIT(); asm volatile("" ::: "memory");
    const int c = lane & 7;
#pragma unroll
    for (int j = 0; j < 4; ++j) { const int n = (lane >> 3) + 8 * j; const LAS float* s = scr + (8 * c) * 33 + n;
        u32x4 o; o.x = pk(s[0 * 33], s[1 * 33]); o.y = pk(s[2 * 33], s[3 * 33]); o.z = pk(s[4 * 33], s[5 * 33]); o.w = pk(s[6 * 33], s[7 * 33]);
        *(u32x4*)(dst + (size_t)(drow0 + n) * K + k0 + 8 * c) = o; }
    LDS_WAIT(); asm volatile("" ::: "memory");
}
__device__ __forceinline__ void tr_plain(const float* W, int ldw, const float* g, int K, int N, bf16_t* dst, int drow_off, int item, LAS float* scr, int lane) {
    const int nnb = N / 32, kb = item / nnb, nb = item % nnb; tr_item(W, ldw, g, K, dst, kb * 64, nb * 32, drow_off + nb * 32, scr, lane);
}
__device__ __forceinline__ void tr_gu(const float* W, const float* g, bf16_t* dst, int upoff, int item, LAS float* scr, int lane) {
    const int nnb = FF / 32, kb = item / nnb, nb = item % nnb, n0 = nb * 32; tr_item(W, FF, g, D, dst, kb * 64, n0, (n0 >> 7) * 256 + (n0 & 127) + upoff, scr, lane);
}
__device__ __forceinline__ void conv_phase(const Ctx& C, const Args& a, int l) {
    LAS float* scr = (LAS float*)(C.lds + C.wave * 16384);
    unsigned char* ws = a.ws;
    const int gw = C.blk * 8 + C.wave, NGW = C.G * 8, lane = C.lane;
    constexpr int I_GU = 16 * 88, I_DN = 44 * 32, I_IN = 16 * 112, I_SQ = 16 * 32;
    const int n_layer = 6 * I_GU + I_IN + 3 * I_SQ;
    const int n_items = n_layer + (l == 0 ? 4 * I_SQ : 0);
    for (int it = gw; it < n_items; it += NGW) {
        int r = it;
        if (r < I_GU) { tr_gu(a.in[3] + (size_t)l * D * FF, a.in[2] + l * D, (bf16_t*)(ws + W_GU1), 0, r, scr, lane); continue; } r -= I_GU;
        if (r < I_GU) { tr_gu(a.in[4] + (size_t)l * D * FF, a.in[2] + l * D, (bf16_t*)(ws + W_GU1), 128, r, scr, lane); continue; } r -= I_GU;
        if (r < I_DN) { tr_plain(a.in[5] + (size_t)l * FF * D, D, nullptr, FF, D, (bf16_t*)(ws + W_D1), 0, r, scr, lane); continue; } r -= I_DN;
        if (r < I_GU) { tr_gu(a.in[22] + (size_t)l * D * FF, a.in[21] + l * D, (bf16_t*)(ws + W_GU2), 0, r, scr, lane); continue; } r -= I_GU;
        if (r < I_GU) { tr_gu(a.in[23] + (size_t)l * D * FF, a.in[21] + l * D, (bf16_t*)(ws + W_GU2), 128, r, scr, lane); continue; } r -= I_GU;
        if (r < I_DN) { tr_plain(a.in[24] + (size_t)l * FF * D, D, nullptr, FF, D, (bf16_t*)(ws + W_D2), 0, r, scr, lane); continue; } r -= I_DN;
        if (r < I_IN) { tr_plain(a.in[7] + (size_t)l * D * NIN, NIN, a.in[6] + l * D, D, NINP, (bf16_t*)(ws + W_IN), 0, r, scr, lane); continue; } r -= I_IN;
        if (r < I_SQ) { tr_plain(a.in[12] + (size_t)l * D * D, D, nullptr, D, D, (bf16_t*)(ws + W_OUT), 0, r, scr, lane); continue; } r -= I_SQ;
        if (r < I_SQ) { tr_plain(a.in[15] + (size_t)l * D * D, D, a.in[13] + l * D, D, D, (bf16_t*)(ws + W_XQ), 0, r, scr, lane); continue; } r -= I_SQ;
        if (r < I_SQ) { tr_plain(a.in[20] + (size_t)l * D * D, D, nullptr, D, D, (bf16_t*)(ws + W_XO), 0, r, scr, lane); continue; } r -= I_SQ;
        { const int which = r / I_SQ, rr = r % I_SQ, ll = which >> 1, kv = which & 1;
          tr_plain(a.in[kv ? 17 : 16] + (size_t)ll * D * D, D, a.in[14] + ll * D, D, D, (bf16_t*)(ws + WS_WKV), ll * 2048 + kv * 1024, rr, scr, lane); }
    }
    if (l == 0) {
        float* ss0 = (float*)(ws + WS_SS); float* ssm = (float*)(ws + WS_SSM);
        for (int m0 = gw; m0 < M + MM; m0 += 2 * NGW) {
            f32x4 v[2][4]; float sq[2];
#pragma unroll
            for (int u = 0; u < 2; ++u) { const int m = m0 + u * NGW; if (m < M + MM) { const bool isx = m < M; const int row = isx ? m : m - M;
                const f32x4* xr = (const f32x4*)((isx ? a.in[0] : a.in[1]) + (size_t)row * D) + lane;
#pragma unroll
                for (int j = 0; j < 4; ++j) v[u][j] = xr[64 * j]; } }
#pragma unroll
            for (int u = 0; u < 2; ++u) { const int m = m0 + u * NGW; if (m < M + MM) { const bool isx = m < M; const int row = isx ? m : m - M;
                bf16_t* dst = (bf16_t*)(ws + (isx ? WS_XB : WS_MEMB)) + (size_t)row * D; float s = 0.f;
#pragma unroll
                for (int j = 0; j < 4; ++j) s += (v[u][j].x * v[u][j].x + v[u][j].y * v[u][j].y) + (v[u][j].z * v[u][j].z + v[u][j].w * v[u][j].w);
                s = wave_sum(s); sq[u] = s;
#pragma unroll
                for (int j = 0; j < 4; ++j) { u32x2 w; w.x = pk(v[u][j].x, v[u][j].y); w.y = pk(v[u][j].z, v[u][j].w); *((u32x2*)dst + lane + 64 * j) = w; }
                if (lane < 4) (isx ? ss0 : ssm)[(size_t)row * 4 + lane] = (lane == 0) ? sq[u] : 0.f; } }
        }
        bf16_t* wgb = (bf16_t*)(ws + WS_WGB);
        for (int idx = C.blk * 512 + C.tid; idx < 2 * 16 * 512; idx += C.G * 512) {
            const int ll = idx >> 13, j = (idx >> 9) & 15, k = (idx & 511) * 2;
            float w0 = 0.f, w1 = 0.f;
            if (j < 8) { w0 = a.in[6][ll * D + k] * a.in[7][(size_t)ll * D * NIN + (size_t)k * NIN + NINP + j]; w1 = a.in[6][ll * D + k + 1] * a.in[7][(size_t)ll * D * NIN + (size_t)(k + 1) * NIN + NINP + j]; }
            ((unsigned*)wgb)[idx] = pk(w0, w1);
        }
        if (C.blk == 0 && C.tid < 64) ((unsigned*)(ws + WS_CTL))[C.tid * 64] = 0u;
    }
}

__device__ __forceinline__ void gates_pass(const Ctx& C, const Args& a, int l, const float* ss) {
    const int hb = C.G / 2;
    if (C.blk < hb) return;
    unsigned char* ws = a.ws;
    const bf16_t* xbp = (const bf16_t*)(ws + WS_XB); const bf16_t* wgb = (const bf16_t*)(ws + WS_WGB) + (size_t)l * 16 * 1024;
    float* gi = (float*)(ws + WS_GI); float* gf = (float*)(ws + WS_GF);
    const float* bg = a.in[8] + l * 8;
    const int lane = C.lane, fr = lane & 15, fq = lane >> 4;
    const bool grp = a.use_group != 0;
    const int gw = grp ? (((C.blk - hb) >> 3) * 8 + C.wave) : ((C.blk - hb) * 8 + C.wave), NGW = grp ? ((((C.G - hb) + 7) >> 3) * 8) : ((C.G - hb) * 8);
    const int tbase = grp ? (C.blk & 7) * (SEQ / 16) : 0, tend = grp ? tbase + SEQ / 16 : M / 16;
    for (int task = tbase + gw; task < tend; task += NGW) {
        const int row0 = task * 16;
        const bf16_t* ap = xbp + (size_t)(row0 + fr) * D + 8 * fq; const bf16_t* bp = wgb + fr * 1024 + 8 * fq;
        f32x4 acc = (f32x4){0.f, 0.f, 0.f, 0.f};
#pragma unroll 8
        for (int kk = 0; kk < 32; ++kk) acc = mfma16(*(const bf16x8*)(ap + 32 * kk), *(const bf16x8*)(bp + 32 * kk), acc);
        if (fr < 8) {
            const int r0 = row0 + 4 * fq, b = r0 >> 11, s = r0 & 2047, h = fr & 3; const float bias = bg[fr];
            f32x4 o;
#pragma unroll
            for (int e = 0; e < 4; ++e) { const float pre = acc[e] * rowscale(ss, r0 + e) + bias; o[e] = (fr < 4) ? pre : fminf(pre, 0.f) - flog(1.f + fexp(-fabsf(pre))); }
            *(f32x4*)((fr < 4 ? gi : gf) + (size_t)(b * 4 + h) * SEQ + s) = o;
        }
    }
}

constexpr int SB_KS = 72;
constexpr int SB_BUF = 2 * 64 * SB_KS * 2;
template <bool MASKED>
__device__ __forceinline__ void sb_tile(const LAS bf16_t* Ks, const LAS bf16_t* Vs, int k0, int tq, int fr, int fq, const bf16x8 (&qf)[2],
                                        const bf16x8 UA, const bf16x8 UB, const bf16x8 ONES, f32x4 (&oacc)[4], float& carry) {
    f32x4 z[4];
#pragma unroll
    for (int i = 0; i < 4; ++i) {
        z[i] = (f32x4){0.f, 0.f, 0.f, 0.f};
#pragma unroll
        for (int kk = 0; kk < 2; ++kk) { const bf16x8 kf = *(const LAS bf16x8*)(Ks + (16 * i + fr) * SB_KS + 32 * kk + 8 * fq); z[i] = mfma16(kf, qf[kk], z[i]); }
    }
    float Lv[4][4], zl[4][4];
    const int lim = tq - k0 - 4 * fq;
#pragma unroll
    for (int i = 0; i < 4; ++i)
#pragma unroll
        for (int e = 0; e < 4; ++e) {
            float zz = z[i][e] * 0.18033688011112042f;
            if (MASKED) zz = (16 * i + e < lim) ? zz : -1e30f;
            const float sp = fmaxf(zz, 0.f) + __builtin_amdgcn_logf(1.f + __builtin_amdgcn_exp2f(-fabsf(zz)));
            Lv[i][e] = -sp; zl[i][e] = zz - sp;
        }
    bf16x8 hi[2];
#pragma unroll
    for (int kk = 0; kk < 2; ++kk) hi[kk] = mk8u(pk(Lv[2 * kk][0], Lv[2 * kk][1]), pk(Lv[2 * kk][2], Lv[2 * kk][3]), pk(Lv[2 * kk + 1][0], Lv[2 * kk + 1][1]), pk(Lv[2 * kk + 1][2], Lv[2 * kk + 1][3]));
    f32x4 tot = (f32x4){0.f, 0.f, 0.f, 0.f};
#pragma unroll
    for (int kk = 0; kk < 2; ++kk) tot = mfma16(ONES, hi[kk], tot);
    unsigned pw[2][4];
#pragma unroll
    for (int io = 0; io < 4; ++io) {
        f32x4 lt = (f32x4){carry, carry, carry, carry};
        { const bf16x8 ud = (io & 1) ? UB : UA; lt = mfma16(ud, hi[io >> 1], lt); }
        if (io < 2) lt = mfma16(ONES, hi[1], lt);
        float av[4];
#pragma unroll
        for (int e = 0; e < 4; ++e) av[e] = __builtin_amdgcn_exp2f(zl[io][e] + lt[e]);
        pw[io >> 1][(io & 1) * 2 + 0] = pk(av[0], av[1]); pw[io >> 1][(io & 1) * 2 + 1] = pk(av[2], av[3]);
    }
    const bf16x8 P0 = mk8u(pw[0][0], pw[0][1], pw[0][2], pw[0][3]), P1 = mk8u(pw[1][0], pw[1][1], pw[1][2], pw[1][3]);
#pragma unroll
    for (int dt = 0; dt < 4; ++dt) {
        const LAS bf16_t* vr = Vs + (4 * fq + (fr >> 2)) * SB_KS + 16 * dt + 4 * (fr & 3);
        const bf16x8 v0 = mk8(trd(vr), trd(vr + 16 * SB_KS)), v1 = mk8(trd(vr + 32 * SB_KS), trd(vr + 48 * SB_KS));
        oacc[dt] = mfma16(v0, P0, oacc[dt]); oacc[dt] = mfma16(v1, P1, oacc[dt]);
    }
    carry += tot[0];
}
__device__ __forceinline__ void sb_unit(const Ctx& C, const bf16_t* proj, bf16_t* mixo, int b, int h, int qb) {
    const int tid = C.tid, lane = C.lane, wid = C.wave, fr = lane & 15, fq = lane >> 4;
    const int q0 = qb * 128, tq = q0 + wid * 16 + fr;
    const size_t rowbase = (size_t)b * SEQ;
    bf16x8 qf[2];
    { const bf16_t* qp = proj + (rowbase + tq) * NINP + h * 64 + 8 * fq; qf[0] = *(const bf16x8*)qp; qf[1] = *(const bf16x8*)(qp + 32); }
    unsigned dg0, dg1;
    { const int d = fr - 4 * fq; dg0 = (0 > d ? 0x3F80u : 0u) | (1 > d ? 0x3F800000u : 0u); dg1 = (2 > d ? 0x3F80u : 0u) | (3 > d ? 0x3F800000u : 0u); }
    const bf16x8 UA = mk8u(dg0, dg1, 0x3F803F80u, 0x3F803F80u), UB = mk8u(0u, 0u, dg0, dg1);
    const bf16x8 ONES = mk8u(0x3F803F80u, 0x3F803F80u, 0x3F803F80u, 0x3F803F80u);
    f32x4 oacc[4];
#pragma unroll
    for (int i = 0; i < 4; ++i) oacc[i] = (f32x4){0.f, 0.f, 0.f, 0.f};
    float carry = 0.f;
    const int jt_max = 2 * qb + 1;
    const int ss_ = tid >> 3, sc_ = tid & 7;
    const bf16_t* kvp = proj + (rowbase + ss_) * NINP + h * 64 + 8 * sc_;
    u32x4 kreg, vreg;
    { const bf16_t* p = kvp + (size_t)(jt_max * 64) * NINP; kreg = *(const u32x4*)(p + 512); vreg = *(const u32x4*)(p + 1024); }
    int cur = 0;
    volatile LAS int* dflag = (volatile LAS int*)(C.lds + MISC_OFF) + 16;
    if (lane == 0) { dflag[wid] = 0; dflag[8 + wid] = 0; }
    int par = 0;
    for (int jt = jt_max; jt >= 0; --jt) {
        LAS unsigned char* buf = C.lds + cur * SB_BUF;
        LAS bf16_t* Ks = (LAS bf16_t*)buf; LAS bf16_t* Vs = (LAS bf16_t*)(buf + 64 * SB_KS * 2);
        *(LAS u32x4*)(Ks + ss_ * SB_KS + 8 * sc_) = kreg;
        *(LAS u32x4*)(Vs + ss_ * SB_KS + 8 * sc_) = vreg;
        if (jt > 0) { const bf16_t* p = kvp + (size_t)((jt - 1) * 64) * NINP; kreg = *(const u32x4*)(p + 512); vreg = *(const u32x4*)(p + 1024); }
        LBAR();
        { const int f = dflag[(par ^ 1) * 8 + (lane & 7)];
          if (__builtin_amdgcn_readfirstlane(__builtin_popcountll(__ballot(f != 0))) == 64) break; }
        const int k0 = jt * 64;
        if (k0 < q0 + wid * 16 + 15 && __ballot(carry < -160.f) != ~0ull) {
            if (k0 + 63 >= q0 + wid * 16) sb_tile<true>(Ks, Vs, k0, tq, fr, fq, qf, UA, UB, ONES, oacc, carry);
            else sb_tile<false>(Ks, Vs, k0, tq, fr, fq, qf, UA, UB, ONES, oacc, carry);
        }
        { const bool dead = __ballot(carry < -160.f) == ~0ull; if (lane == 0) dflag[par * 8 + wid] = dead ? 1 : 0; }
        cur ^= 1; par ^= 1;
    }
    bf16_t* op = mixo + (rowbase + tq) * D + h * 64 + 4 * fq;
#pragma unroll
    for (int dt = 0; dt < 4; ++dt) { u32x2 w; w.x = pk(oacc[dt][0], oacc[dt][1]); w.y = pk(oacc[dt][2], oacc[dt][3]); *(u32x2*)(op + 16 * dt) = w; }
    LBAR();
}

constexpr int ML_QS = 136, ML_VS = 152, ML_CTS = 136;
constexpr int ML_Q = 0, ML_K = ML_Q + 64 * ML_QS * 2, ML_V = ML_K + 64 * ML_QS * 2, ML_CT = ML_V + 64 * ML_VS * 2,
              ML_VEC = ML_CT + 144 * ML_CTS * 2, ML_EX = ML_VEC + 8 * 64 * 4, ML_CW = ML_EX + 2 * 64 * 4, ML_END = ML_CW + 10 * 128 * 4;
static_assert(ML_END <= RING_BYTES, "mlstm LDS");
constexpr int ML_SLOT = 144 * 128 * 2;
__device__ __forceinline__ unsigned char* ml_slot(float* dout, int item) { return (unsigned char*)dout + (size_t)(item >> 7) * ((size_t)SEQ * D * 4) + (size_t)(item & 127) * ML_SLOT; }
template <int MODE>
__device__ __forceinline__ void mlstm_item(const Ctx& C, const Args& a, int l, int item) {
    const int tid = C.tid, lane = C.lane, wid = C.wave, fr = lane & 15, fq = lane >> 4;
    const int b = item >> 7, h = (item >> 5) & 3, c = item & 31;
    unsigned char* ws = a.ws;
    const bf16_t* proj = (const bf16_t*)(ws + WS_BIG); bf16_t* mixo = (bf16_t*)(ws + WS_MIXO);
    const float* gi = (const float*)(ws + WS_GI) + (size_t)(b * 4 + h) * SEQ; const float* gf = (const float*)(ws + WS_GF) + (size_t)(b * 4 + h) * SEQ;
    float* mlA = (float*)(ws + WS_MLS); float* mlG = mlA + 1024; float* mlM = mlA + 2048;
    LAS bf16_t* Qs = (LAS bf16_t*)(C.lds + ML_Q); LAS bf16_t* Ks = (LAS bf16_t*)(C.lds + ML_K); LAS bf16_t* Vs = (LAS bf16_t*)(C.lds + ML_V); LAS bf16_t* Ct = (LAS bf16_t*)(C.lds + ML_CT);
    LAS float* vec = (LAS float*)(C.lds + ML_VEC);
    LAS float* ex = (LAS float*)(C.lds + ML_EX); LAS float* cw = (LAS float*)(C.lds + ML_CW);
    const size_t rowbase = (size_t)b * SEQ;
    const int dch = tid & 15, rg = tid >> 4;
    const int vs = tid >> 3, vc = tid & 7;
    const int tt = wid & 3, half = wid >> 2;
    const float q_scale = 0.08838834764831845f;
    const int s0 = c * 64;
    {
        float cwr[3];
        { const float* wc_ = a.in[9] + (size_t)l * 4 * 1024; const float* bc_ = a.in[10] + (size_t)l * 1024;
#pragma unroll
          for (int k = 0; k < 2; ++k) { const int i = tid + 512 * k; const int which = i >> 9, j = (i >> 7) & 3, d = i & 127; cwr[k] = wc_[j * 1024 + which * 512 + h * 128 + d]; }
          { const int which = (tid >> 7) & 1, d = tid & 127; cwr[2] = bc_[which * 512 + h * 128 + d]; } }
        u32x4 cst[5];
        if (MODE == 1) { const u32x4* src = (const u32x4*)ml_slot(a.out, item);
#pragma unroll
            for (int k = 0; k < 5; ++k) { const int i = tid + 512 * k; cst[k] = (i < 144 * 16) ? src[i] : (u32x4){0u, 0u, 0u, 0u}; } }
        u32x4 ur[2][5];
#pragma unroll
        for (int which = (MODE == 0 ? 1 : 0); which < 2; ++which)
#pragma unroll
            for (int i = 0; i < 5; ++i) {
                const int sr = s0 + 2 * rg - 3 + i;
                if (sr >= 0) ur[which][i] = *(const u32x4*)(proj + (rowbase + sr) * NINP + h * 128 + 8 * dch + 1536 + 512 * which);
                else ur[which][i] = (u32x4){0u, 0u, 0u, 0u};
            }
        const bf16_t* vp = proj + (rowbase + s0 + vs) * NINP + 2560 + h * 128 + 16 * vc;
        const u32x4 v0 = *(const u32x4*)vp, v1 = *(const u32x4*)(vp + 8);
        float lf = 0.f, li = 0.f;
        if (wid == 0) { lf = gf[s0 + lane]; li = gi[s0 + lane]; }
        cw[tid] = cwr[0]; cw[tid + 512] = cwr[1]; if (tid < 256) cw[1024 + tid] = cwr[2];
        LBAR();
        if (tid < 128) { unsigned o1 = 0x3F803F80u; asm volatile("" : "+v"(o1));
            const u32x4 one = (u32x4){o1, o1, o1, o1}; *(LAS u32x4*)(Vs + (tid >> 1) * ML_VS + 128 + 8 * (tid & 1)) = one; }
        *(LAS u32x4*)(Vs + vs * ML_VS + 16 * vc) = v0; *(LAS u32x4*)(Vs + vs * ML_VS + 16 * vc + 8) = v1;
        if (MODE == 1) {
#pragma unroll
            for (int k = 0; k < 5; ++k) { const int i = tid + 512 * k; if (i < 144 * 16) { const int e = i >> 4, ch = i & 15; *(LAS u32x4*)(Ct + e * ML_CTS + 8 * ch) = cst[k]; } } }
#pragma unroll
        for (int which = (MODE == 0 ? 1 : 0); which < 2; ++which) {
#pragma unroll
            for (int rr = 0; rr < 2; ++rr) {
                f32x4 ya = *(const LAS f32x4*)(cw + 1024 + which * 128 + 8 * dch), yb = *(const LAS f32x4*)(cw + 1024 + which * 128 + 8 * dch + 4);
#pragma unroll
                for (int j = 0; j < 4; ++j) {
                    const u32x4 u = ur[which][rr + j];
                    ya = ya + (f32x4){bflo(u.x), bfhi(u.x), bflo(u.y), bfhi(u.y)} * *(const LAS f32x4*)(cw + which * 512 + j * 128 + 8 * dch);
                    yb = yb + (f32x4){bflo(u.z), bfhi(u.z), bflo(u.w), bfhi(u.w)} * *(const LAS f32x4*)(cw + which * 512 + j * 128 + 8 * dch + 4);
                }
                float y[8] = {ya.x, ya.y, ya.z, ya.w, yb.x, yb.y, yb.z, yb.w};
#pragma unroll
                for (int i = 0; i < 8; ++i) { y[i] = y[i] * sigmoidf_(y[i]); if (!which) y[i] *= q_scale; }
                const int r = 2 * rg + rr;
                u32x4 w; w.x = pk(y[0], y[1]); w.y = pk(y[2], y[3]); w.z = pk(y[4], y[5]); w.w = pk(y[6], y[7]);
                *(LAS u32x4*)((which ? Ks : Qs) + r * ML_QS + 8 * dch) = w;
            }
        }
        if (wid == 0) {
            float bc = lf;
#pragma unroll
            for (int o = 1; o < 64; o <<= 1) { const float t = __shfl_up(bc, o); if (lane >= o) bc += t; }
            const float ct = li - bc; float pm = ct;
#pragma unroll
            for (int o = 1; o < 64; o <<= 1) { const float t = __shfl_up(pm, o); if (lane >= o) pm = fmaxf(pm, t); }
            const float b63 = __shfl(bc, 63);
            if (MODE == 0) {
                const float a_c = b63 + __shfl(pm, 63);
                vec[256 + lane] = fexp(b63 + ct - a_c);
                if (lane == 0) { mlA[item] = a_c; mlG[item] = b63; }
            } else {
                const float m_st = mlM[item];
                const float mt = bc + fmaxf(pm, m_st);
                vec[lane] = bc; vec[64 + lane] = ct; vec[128 + lane] = mt; vec[192 + lane] = fexp(bc + m_st - mt); vec[320 + lane] = fexp(-mt);
            }
        }
    }
    LBAR();
    if (MODE == 1) {
        const int t = 16 * tt + fr;
        bf16x8 qfr[4];
#pragma unroll
        for (int kk = 0; kk < 4; ++kk) qfr[kk] = *(const LAS bf16x8*)(Qs + t * ML_QS + 32 * kk + 8 * fq);
        const float rowterm = vec[t] - vec[128 + t], winter = vec[192 + t], einv = vec[320 + t];
        unsigned pw[2][4];
#pragma unroll
        for (int i = 0; i < 4; ++i) {
            f32x4 sa = (f32x4){0.f, 0.f, 0.f, 0.f};
#pragma unroll
            for (int kk = 0; kk < 4; ++kk) { const bf16x8 kf = *(const LAS bf16x8*)(Ks + (16 * i + fr) * ML_QS + 32 * kk + 8 * fq); sa = mfma16(kf, qfr[kk], sa); }
            const f32x4 ctv = *(const LAS f32x4*)(vec + 64 + 16 * i + 4 * fq);
            float sc[4];
#pragma unroll
            for (int e = 0; e < 4; ++e) { const int s = 16 * i + 4 * fq + e; sc[e] = (s <= t) ? sa[e] * fexp(rowterm + ctv[e]) : 0.f; }
            pw[i >> 1][(i & 1) * 2 + 0] = pk(sc[0], sc[1]); pw[i >> 1][(i & 1) * 2 + 1] = pk(sc[2], sc[3]);
        }
        const bf16x8 P0 = mk8u(pw[0][0], pw[0][1], pw[0][2], pw[0][3]), P1 = mk8u(pw[1][0], pw[1][1], pw[1][2], pw[1][3]);
        f32x4 num[5];
#pragma unroll
        for (int ei = 0; ei < 5; ++ei) {
            const int et = (ei == 4) ? 8 : 4 * half + ei;
            const LAS bf16_t* vr = Vs + (4 * fq + (fr >> 2)) * ML_VS + 16 * et + 4 * (fr & 3);
            const bf16x8 v0 = mk8(trd(vr), trd(vr + 16 * ML_VS)), v1 = mk8(trd(vr + 32 * ML_VS), trd(vr + 48 * ML_VS));
            f32x4 intra = (f32x4){0.f, 0.f, 0.f, 0.f}; intra = mfma16(v0, P0, intra); intra = mfma16(v1, P1, intra);
            f32x4 inter = (f32x4){0.f, 0.f, 0.f, 0.f};
#pragma unroll
            for (int kk = 0; kk < 4; ++kk) { const bf16x8 cf = *(const LAS bf16x8*)(Ct + (16 * et + fr) * ML_CTS + 32 * kk + 8 * fq); inter = mfma16(cf, qfr[kk], inter); }
            num[ei] = intra + inter * winter;
        }
        const float den = fmaxf(fabsf(num[4][0]), einv); const float dinv = 1.f / den;
        float sq = 0.f;
#pragma unroll
        for (int ei = 0; ei < 4; ++ei) { num[ei] = num[ei] * dinv; sq += (num[ei][0] * num[ei][0] + num[ei][1] * num[ei][1]) + (num[ei][2] * num[ei][2] + num[ei][3] * num[ei][3]); }
        sq += __shfl_xor(sq, 16); sq += __shfl_xor(sq, 32);
        if (fq == 0) ex[half * 64 + t] = sq;
        LBAR();
        const float tot = ex[t] + ex[64 + t]; const float rn = __builtin_amdgcn_rsqf(tot * (1.f / 128.f) + EPS);
        const float* gh = a.in[11] + (size_t)l * 512 + h * 128;
        const bf16_t* og = proj + (rowbase + s0 + t) * NINP + 3072 + h * 128;
        bf16_t* op = mixo + (rowbase + s0 + t) * D + 512 + h * 128;
#pragma unroll
        for (int ei = 0; ei < 4; ++ei) {
            const int e0 = 16 * (4 * half + ei) + 4 * fq;
            const f32x4 g4 = *(const f32x4*)(gh + e0); const u32x2 o2 = *(const u32x2*)(og + e0);
            const float y0 = num[ei][0] * rn * g4.x * sigmoidf_(bflo(o2.x)), y1 = num[ei][1] * rn * g4.y * sigmoidf_(bfhi(o2.x));
            const float y2 = num[ei][2] * rn * g4.z * sigmoidf_(bflo(o2.y)), y3 = num[ei][3] * rn * g4.w * sigmoidf_(bfhi(o2.y));
            u32x2 w; w.x = pk(y0, y1); w.y = pk(y2, y3); *(u32x2*)(op + e0) = w;
        }
    }
    if (MODE == 0) {
        bf16x8 kw[2];
#pragma unroll
        for (int kk = 0; kk < 2; ++kk) {
            const LAS bf16_t* kr = Ks + (32 * kk + 8 * fq + (fr >> 2)) * ML_QS + 16 * wid + 4 * (fr & 3);
            const u32x2 k0 = trd(kr), k1 = trd(kr + 4 * ML_QS);
            const f32x4 w0 = *(const LAS f32x4*)(vec + 256 + 32 * kk + 8 * fq), w1 = *(const LAS f32x4*)(vec + 256 + 32 * kk + 8 * fq + 4);
            kw[kk] = mk8u(pk(bflo(k0.x) * w0.x, bfhi(k0.x) * w0.y), pk(bflo(k0.y) * w0.z, bfhi(k0.y) * w0.w),
                          pk(bflo(k1.x) * w1.x, bfhi(k1.x) * w1.y), pk(bflo(k1.y) * w1.z, bfhi(k1.y) * w1.w));
        }
        bf16_t* slot = (bf16_t*)ml_slot(a.out, item);
#pragma unroll
        for (int et = 0; et < 9; ++et) {
            f32x4 cacc = (f32x4){0.f, 0.f, 0.f, 0.f};
#pragma unroll
            for (int kk = 0; kk < 2; ++kk) {
                const LAS bf16_t* vr = Vs + (32 * kk + 8 * fq + (fr >> 2)) * ML_VS + 16 * et + 4 * (fr & 3);
                const bf16x8 vf = mk8(trd(vr), trd(vr + 4 * ML_VS));
                cacc = mfma16(kw[kk], vf, cacc);
            }
            u32x2 w; w.x = pk(cacc[0], cacc[1]); w.y = pk(cacc[2], cacc[3]);
            *(u32x2*)(slot + (size_t)(16 * et + fr) * 128 + 16 * wid + 4 * fq) = w;
        }
    }
    LBAR();
}

__device__ __forceinline__ void mlstm_scan(const Ctx& C, const Args& a) {
    unsigned char* ws = a.ws;
    const float* mlA = (const float*)(ws + WS_MLS); const float* mlG = mlA + 1024; float* mlM = (float*)(ws + WS_MLS) + 2048;
    const bool gm = a.use_group != 0;
    for (int w = gm ? (C.blk & 7) * 32 + (C.blk >> 3) : C.blk; w < (gm ? ((C.blk & 7) + 1) * 32 : 256); w += (gm ? (C.G >> 3) : C.G)) {
        const int bh = w >> 3, slice = w & 7;
        if (C.tid < 384) {
            const int widx = slice * 1152 + C.tid;
            float st[6] = {0.f, 0.f, 0.f, 0.f, 0.f, 0.f}; float m = 0.f;
            unsigned sw[32][3];
#pragma unroll
            for (int cc = 0; cc < 32; ++cc) { const unsigned* sp = (const unsigned*)ml_slot(a.out, bh * 32 + cc) + widx;
#pragma unroll
                for (int j = 0; j < 3; ++j) sw[cc][j] = sp[384 * j]; }
#pragma unroll
            for (int cc = 0; cc < 32; ++cc) {
                const int item = bh * 32 + cc;
                const float a_c = mlA[item], g_c = mlG[item];
                const float m_new = fmaxf(g_c + m, a_c), al = fexp(g_c + m - m_new), be = fexp(a_c - m_new);
                unsigned* dp = (unsigned*)ml_slot(a.out, item) + widx;
#pragma unroll
                for (int j = 0; j < 3; ++j) {
                    dp[384 * j] = pk(st[2 * j], st[2 * j + 1]);
                    st[2 * j] = al * st[2 * j] + be * bflo(sw[cc][j]); st[2 * j + 1] = al * st[2 * j + 1] + be * bfhi(sw[cc][j]);
                }
                if (slice == 0 && C.tid == 0) mlM[item] = m;
                m = m_new;
            }
        }
    }
}

constexpr int XA_KS = 264;
constexpr int XA_BUF = 64 * XA_KS * 2;
template <bool QL = false>
__device__ __forceinline__ void xattn_unit(const Ctx& C, const bf16_t* qn, const bf16_t* kv, bf16_t* obuf, int l, int b, int h, int qb, const LAS bf16_t* qlds = nullptr, int kvoff = 0) {
    const int tid = C.tid, lane = C.lane, wid = C.wave, fr = lane & 15, fq = lane >> 4;
    const int t = qb * 128 + wid * 16 + fr;
    const size_t qrow = (size_t)b * SEQ + t;
    bf16x8 qf[8];
    if (QL) { const LAS bf16_t* qp = qlds + (wid * 16 + fr) * XA_KS + 8 * fq;
#pragma unroll
      for (int kk = 0; kk < 8; ++kk) qf[kk] = *(const LAS bf16x8*)(qp + 32 * kk); }
    else { const bf16_t* qp = qn + qrow * D + (size_t)b * (GX_Q / 2) + h * 256 + 8 * fq;
#pragma unroll
      for (int kk = 0; kk < 8; ++kk) qf[kk] = *(const bf16x8*)(qp + 32 * kk); }
    const int ss_ = tid >> 3, sc_ = tid & 7;
    const bf16_t* kbase = kv + ((size_t)b * MEML + ss_) * 4096 + l * 2048 + h * 256 + 8 * sc_;
#define XA_SRC(s_) (((s_) < 4) ? kbase + (size_t)(64 * (s_)) * 4096 : kbase + 1024 + (size_t)(64 * ((s_) - 4)) * 4096)
    u32x4 st[2][4];
#pragma unroll
    for (int i = 0; i < 4; ++i) { st[0][i] = *(const u32x4*)(XA_SRC(0) + 64 * i); st[1][i] = *(const u32x4*)(XA_SRC(1) + 64 * i); }
    f32x4 S[16];
    int cur = 0;
#pragma unroll
    for (int c = 0; c < 4; ++c) {
        LAS bf16_t* Kc = (LAS bf16_t*)(C.lds + kvoff + cur * XA_BUF);
#pragma unroll
        for (int i = 0; i < 4; ++i) *(LAS u32x4*)(Kc + ss_ * XA_KS + 8 * sc_ + 64 * i) = st[c & 1][i];
        { const bf16_t* nb = XA_SRC(c + 2);
#pragma unroll
          for (int i = 0; i < 4; ++i) st[c & 1][i] = *(const u32x4*)(nb + 64 * i); }
        LBAR();
#pragma unroll
        for (int i = 0; i < 4; ++i) {
            f32x4 sa = (f32x4){0.f, 0.f, 0.f, 0.f};
#pragma unroll
            for (int kk = 0; kk < 8; ++kk) { const bf16x8 kf = *(const LAS bf16x8*)(Kc + (16 * i + fr) * XA_KS + 32 * kk + 8 * fq); sa = mfma16(kf, qf[kk], sa); }
            S[4 * c + i] = sa;
        }
        cur ^= 1;
    }
    float mx = -1e30f;
#pragma unroll
    for (int i = 0; i < 16; ++i) mx = fmaxf(mx, fmaxf(fmaxf(S[i][0], S[i][1]), fmaxf(S[i][2], S[i][3])));
    mx = fmaxf(mx, __shfl_xor(mx, 16)); mx = fmaxf(mx, __shfl_xor(mx, 32));
    float sum = 0.f;
#pragma unroll
    for (int i = 0; i < 16; ++i)
#pragma unroll
        for (int e = 0; e < 4; ++e) { const float p = fexp((S[i][e] - mx) * 0.0625f); S[i][e] = p; sum += p; }
    sum += __shfl_xor(sum, 16); sum += __shfl_xor(sum, 32);
    bf16x8 pf[8];
#pragma unroll
    for (int k2 = 0; k2 < 8; ++k2) pf[k2] = mk8u(pk(S[2 * k2][0], S[2 * k2][1]), pk(S[2 * k2][2], S[2 * k2][3]), pk(S[2 * k2 + 1][0], S[2 * k2 + 1][1]), pk(S[2 * k2 + 1][2], S[2 * k2 + 1][3]));
    f32x4 O[16];
#pragma unroll
    for (int i = 0; i < 16; ++i) O[i] = (f32x4){0.f, 0.f, 0.f, 0.f};
#pragma unroll
    for (int c = 0; c < 4; ++c) {
        LAS bf16_t* Vc = (LAS bf16_t*)(C.lds + kvoff + cur * XA_BUF);
#pragma unroll
        for (int i = 0; i < 4; ++i) *(LAS u32x4*)(Vc + ss_ * XA_KS + 8 * sc_ + 64 * i) = st[c & 1][i];
        if (c < 2) { const bf16_t* nb = XA_SRC(c + 6);
#pragma unroll
            for (int i = 0; i < 4; ++i) st[c & 1][i] = *(const u32x4*)(nb + 64 * i); }
        LBAR();
#pragma unroll
        for (int dt = 0; dt < 16; ++dt) {
            const LAS bf16_t* vr = Vc + (4 * fq + (fr >> 2)) * XA_KS + 16 * dt + 4 * (fr & 3);
            const bf16x8 v0 = mk8(trd(vr), trd(vr + 16 * XA_KS)), v1 = mk8(trd(vr + 32 * XA_KS), trd(vr + 48 * XA_KS));
            O[dt] = mfma16(v0, pf[2 * c], O[dt]); O[dt] = mfma16(v1, pf[2 * c + 1], O[dt]);
        }
        cur ^= 1;
    }
    const float inv = 1.f / sum;
    bf16_t* op = obuf + qrow * D + (size_t)b * (GX_Q / 2) + h * 256 + 4 * fq;
#pragma unroll
    for (int dt = 0; dt < 16; ++dt) { u32x2 w; w.x = pk(O[dt][0] * inv, O[dt][1] * inv); w.y = pk(O[dt][2] * inv, O[dt][3] * inv); *(u32x2*)(op + 16 * dt) = w; }
    LBAR();
}

struct EpiQXattn {
    static constexpr bool USE_RT = true, AFTER_DRAIN = true;
    const float* ss; const float* gain; LAS float* P; LAS unsigned char* lds; const bf16_t* kv; bf16_t* obuf; int l;
    __device__ __forceinline__ void operator()(const pg8::Acc& acc, const pg8::Unit& u, int wr, int wc, int fr, int fq, const pg8::RowTab& T) const {
        using namespace pg8;
        float rn[2][4];
#pragma unroll
        for (int ai = 0; ai < 2; ++ai)
#pragma unroll
            for (int m = 0; m < 4; ++m) {
                const float r = rs_get(T, ss, u, ai * HALF + wr * 64 + m * 16 + fr); rn[ai][m] = r; float sq = 0.f;
#pragma unroll
                for (int bj = 0; bj < 2; ++bj)
#pragma unroll
                    for (int n = 0; n < 2; ++n) { const f32x4 v = acc[ai][bj][m][n] * r; sq += (v.x * v.x + v.y * v.y) + (v.z * v.z + v.w * v.w); }
                sq += __shfl_xor(sq, 16); sq += __shfl_xor(sq, 32);
                if (fq == 0) P[(ai * HALF + wr * 64 + m * 16 + fr) * 4 + wc] = sq;
            }
        LBAR();
        f32x4 g[2][2];
#pragma unroll
        for (int bj = 0; bj < 2; ++bj)
#pragma unroll
            for (int n = 0; n < 2; ++n) g[bj][n] = *(const f32x4*)(gain + bj * HALF + wc * 32 + 8 * fq + 4 * n);
#pragma unroll
        for (int ai = 0; ai < 2; ++ai)
#pragma unroll
            for (int m = 0; m < 4; ++m) { const f32x4 p = *(const LAS f32x4*)(P + (ai * HALF + wr * 64 + m * 16 + fr) * 4);
                rn[ai][m] *= __builtin_amdgcn_rsqf(((p.x + p.y) + (p.z + p.w)) * (1.f / 256.f) + EPS); }
        Ctx C2; { int t_ = threadIdx.x; asm volatile("" : "+v"(t_)); C2.tid = t_; C2.lane = t_ & 63; C2.wave = __builtin_amdgcn_readfirstlane(t_ >> 6); } C2.lds = lds; C2.G = gridDim.x; C2.blk = blockIdx.x;
        LAS bf16_t* Qs = (LAS bf16_t*)lds;
        const int b = u.pm >> 3, h = u.pn;
        u32x4 qw[2][4][2];
#pragma unroll
        for (int hf = 0; hf < 2; ++hf)
#pragma unroll
            for (int m = 0; m < 4; ++m)
#pragma unroll
                for (int bj = 0; bj < 2; ++bj) {
                    const f32x4 a = acc[hf][bj][m][0] * rn[hf][m] * g[bj][0], c = acc[hf][bj][m][1] * rn[hf][m] * g[bj][1];
                    u32x4 w; w.x = pk(a.x, a.y); w.y = pk(a.z, a.w); w.z = pk(c.x, c.y); w.w = pk(c.z, c.w); qw[hf][m][bj] = w;
                }
#pragma unroll
        for (int hf = 0; hf < 2; ++hf) {
            LBAR();
#pragma unroll
            for (int m = 0; m < 4; ++m)
#pragma unroll
                for (int bj = 0; bj < 2; ++bj) *(LAS u32x4*)(Qs + (wr * 64 + m * 16 + fr) * XA_KS + bj * HALF + wc * 32 + 8 * fq) = qw[hf][m][bj];
            LBAR();
            xattn_unit<true>(C2, nullptr, kv, obuf, l, b, h, (u.pm & 7) * 2 + hf, Qs, 128 * XA_KS * 2);
        }
    }
};
static_assert(128 * XA_KS * 2 + 2 * XA_BUF <= MISC_OFF, "query tile + K/V chunk buffers below the LDS control words");

#define XB_TMO      128
#define XB_XCNT(j)  (256  + 64 * (j))
#define XB_XSUB(j)  (1280 + 64 * (j))
#define XB_XGEN(j)  (2304 + 64 * (j))
#define XB_TOP      3328
#define XB_TOPGEN   3392
#define XCD_BAR_WORDS 3456
#define XB_SPIN_CAP (1u << 22)
constexpr int CW_BAR = 4096;
constexpr size_t CTL_ZERO_BYTES = 64 * 1024;
__device__ __forceinline__ unsigned xb_ld(unsigned* p)              { return __hip_atomic_load(p, __ATOMIC_RELAXED, __HIP_MEMORY_SCOPE_AGENT); }
__device__ __forceinline__ unsigned xb_add(unsigned* p, unsigned v) { return __hip_atomic_fetch_add(p, v, __ATOMIC_RELAXED, __HIP_MEMORY_SCOPE_AGENT); }
__device__ __forceinline__ unsigned xb_xcc_id() { return (unsigned)__builtin_amdgcn_s_getreg((3 << 11) | 20) & 0xFu; }
#define XB_SPIN(cond, bar) do { unsigned _sp = 0; while (cond) { __builtin_amdgcn_s_sleep(1); \
    if ((++_sp & 255u) == 0u) { if (xb_ld(&(bar)[XB_TMO])) break; if (_sp > XB_SPIN_CAP) { atomicAdd(&(bar)[XB_TMO], 1u); break; } } } } while (0)
struct XcdBarrier { unsigned* bar; unsigned x; volatile LAS unsigned* st; };
__device__ __forceinline__ XcdBarrier xcd_barrier_post(unsigned* bar, volatile LAS unsigned* st) {
    XcdBarrier b; b.bar = bar; b.x = xb_xcc_id(); b.st = st;
    if (threadIdx.x == 0) (void)xb_add(&bar[XB_XCNT(b.x)], 1u);
    return b;
}
__device__ __forceinline__ void xcd_barrier_complete(unsigned* bar, unsigned x, unsigned& nloc, unsigned& nx) {
    const unsigned G = gridDim.x * gridDim.y * gridDim.z;
    unsigned sum, cnt, mine, sp = 0u;
    for (;;) {
        sum = 0u; cnt = 0u; mine = 0u;
#pragma unroll
        for (unsigned j = 0; j < 16; ++j) { const unsigned c = xb_ld(&bar[XB_XCNT(j)]); sum += c; cnt += (c > 0u) ? 1u : 0u; mine = (j == x) ? c : mine; }
        if (sum == G) break;
        __builtin_amdgcn_s_sleep(1);
        if ((++sp & 255u) == 0u) { if (xb_ld(&bar[XB_TMO])) break; if (sp > XB_SPIN_CAP) { atomicAdd(&bar[XB_TMO], 1u); break; } }
    }
    nloc = mine > 0u ? mine : 1u; nx = cnt > 0u ? cnt : 1u;
}
__device__ __forceinline__ void xcd_barrier(const XcdBarrier& b) {
    asm volatile("s_waitcnt vmcnt(0)" ::: "memory");
    __syncthreads();
    if (threadIdx.x == 0) {
        unsigned* bar = b.bar;
        __builtin_amdgcn_s_waitcnt(0);
        unsigned nloc = b.st[0], nx = b.st[1];
        if (nloc == 0u) { xcd_barrier_complete(bar, b.x, nloc, nx); b.st[0] = nloc; b.st[1] = nx; }
        const unsigned old = xb_add(&bar[XB_XSUB(b.x)], 1u);
        const unsigned gen = old / nloc;
        if (old + 1u == (gen + 1u) * nloc) {
            __builtin_amdgcn_fence(__ATOMIC_RELEASE, "agent");
            asm volatile("s_waitcnt vmcnt(0)" ::: "memory");
            const unsigned og = xb_add(&bar[XB_TOP], 1u);
            const unsigned tg = og / nx;
            if (og + 1u == (tg + 1u) * nx) xb_add(&bar[XB_TOPGEN], 1u);
            else XB_SPIN(xb_ld(&bar[XB_TOPGEN]) == tg, bar);
            __builtin_amdgcn_fence(__ATOMIC_ACQUIRE, "agent");
            xb_add(&bar[XB_XGEN(b.x)], 1u);
            asm volatile("s_waitcnt vmcnt(0)" ::: "memory");
        } else {
            XB_SPIN(xb_ld(&bar[XB_XGEN(b.x)]) == gen, bar);
            __builtin_amdgcn_fence(__ATOMIC_ACQUIRE, "agent");
            asm volatile("s_waitcnt vmcnt(0)" ::: "memory");
        }
    }
    __syncthreads();
}

constexpr int CW_GRP = 8192, CW_GMASK = 12288;
template <bool HEAVY>
__device__ __forceinline__ void group_barrier(unsigned* gctr, unsigned target) {
    asm volatile("s_waitcnt vmcnt(0)" ::: "memory");
    __syncthreads();
    if (threadIdx.x == 0) {
        if (HEAVY) { __builtin_amdgcn_fence(__ATOMIC_RELEASE, "agent"); asm volatile("s_waitcnt vmcnt(0)" ::: "memory"); }
        (void)xb_add(gctr, 1u);
        unsigned sp = 0u;
        while (xb_ld(gctr) < target) { __builtin_amdgcn_s_sleep(1); if (++sp > XB_SPIN_CAP) break; }
        __builtin_amdgcn_fence(__ATOMIC_ACQUIRE, "agent");
        asm volatile("s_waitcnt vmcnt(0)" ::: "memory");
    }
    __syncthreads();
}

__global__ void __launch_bounds__(512, 2) fwd_kernel(Args a) {
    extern __shared__ __attribute__((aligned(16))) unsigned char lds_raw[];
    Ctx C; C.lds = (LAS unsigned char*)lds_raw; C.G = gridDim.x; C.blk = blockIdx.x;
    unsigned char* ws = a.ws;
    const int lo = a.ph_lo, hi = a.ph_hi;
#define xb ((bf16_t*)(a.ws + WS_XB))
#define big ((bf16_t*)(a.ws + WS_BIG))
#define mixo ((bf16_t*)(a.ws + WS_MIXO))
#define qn big
#define ob (big + (size_t)(4 * MiB / 2))
#define ssb0 ((float*)(a.ws + WS_SS))
#define ssb1 (ssb0 + (size_t)M * 4)
    LAS float* P = (LAS float*)(C.lds + XSCR_OFF);
    volatile LAS int* misc = (volatile LAS int*)(C.lds + MISC_OFF);
    XcdBarrier xbar; xbar.bar = nullptr; xbar.x = 0; xbar.st = nullptr;
    if (hi - lo > 1) {
        if (threadIdx.x < 2) misc[8 + threadIdx.x] = 0;
        __syncthreads();
        xbar = xcd_barrier_post((unsigned*)(ws + WS_CTL) + CW_BAR, (volatile LAS unsigned*)(misc + 8));
    }
#ifndef PROBE_DUP_LO
#define PROBE_DUP_LO 0
#define PROBE_DUP_N 0
#endif
    unsigned gk = 0u; const unsigned gmembers = (unsigned)((C.G - (C.blk & 7) + 7) / 8);
    int glocal = -1;
    if (a.use_group && hi - lo > 1 && threadIdx.x == 0) __hip_atomic_fetch_or((unsigned*)(ws + WS_CTL) + CW_GMASK + (C.blk & 7), 1u << xb_xcc_id(), __ATOMIC_RELAXED, __HIP_MEMORY_SCOPE_AGENT);
    for (int it = lo; it < hi; ++it) {
        const int rep = (PROBE_DUP_N > 0 && it >= PROBE_DUP_LO + PROBE_DUP_N && it < PROBE_DUP_LO + 2 * PROBE_DUP_N) ? 1 : 0;
        const int ph = (PROBE_DUP_N > 0 && it >= PROBE_DUP_LO + PROBE_DUP_N) ? it - PROBE_DUP_N : it;
        const int l = ph / 13, p = ph % 13;
#define RELAUNDER() do { int t_ = threadIdx.x; asm volatile("" : "+v"(t_)); C.tid = t_; C.lane = t_ & 63; C.wave = __builtin_amdgcn_readfirstlane(t_ >> 6); } while (0)
        RELAUNDER();
        if (p == 0) conv_phase(C, a, l);
        else if (p == 1 || p == 11) {
            pg8::Gemm g{xb, (const bf16_t*)(ws + (p == 1 ? W_GU1 : W_GU2)), M, NGU, D}; pg8::StaticOrder S; S.init(M, NGU, C.G, C.blk);
            pg8::EpiSwiglu E{big, p == 1 ? ssb0 : ssb1};
            pg8::gemm_phase(C.lds, g, S, E);
            if (ph == 1 && rep == 0) {
                pg8::Gemm g2{(const bf16_t*)(ws + WS_MEMB), (const bf16_t*)(ws + WS_WKV), MM, 4096, D}; pg8::StaticOrder S2; S2.init(MM, 4096, C.G, a.use_group ? C.blk : (C.blk + C.G / 2) % C.G); if (a.use_group) S2.direct_hb = C.G / 2;
                pg8::EpiHeadNorm E2{(bf16_t*)(ws + WS_KV), 4096, (const float*)(ws + WS_SSM), a.in[19], a.in[19] + 256, P, 0};
                pg8::gemm_phase(C.lds, g2, S2, E2);
            }
        } else if (p == 2 || p == 12) {
            pg8::Gemm g{big, (const bf16_t*)(ws + (p == 2 ? W_D1 : W_D2)), M, D, FF, GX_H}; pg8::StaticOrder S; S.init(M, D, C.G, C.blk);
            if (ph == 2) { pg8::EpiResid<true, false> E{a.in[0], a.out, xb, ssb1, 0.5f, P}; pg8::gemm_phase(C.lds, g, S, E); }
            else if (ph == NPH - 1) { pg8::EpiResid<false, true> E{a.in[0], a.out, xb, ssb0, 0.5f, P}; pg8::gemm_phase(C.lds, g, S, E); }
            else { pg8::EpiResid<false, false> E{a.in[0], a.out, xb, p == 2 ? ssb1 : ssb0, 0.5f, P}; pg8::gemm_phase(C.lds, g, S, E); }
        } else if (p == 3) {
            pg8::Gemm g{xb, (const bf16_t*)(ws + W_IN), M, NINP, D}; pg8::StaticOrder S; S.init(M, NINP, C.G, C.blk);
            pg8::EpiProj E{big, NINP, ssb1};
            pg8::gemm_phase(C.lds, g, S, E);
            RELAUNDER();
            gates_pass(C, a, l, ssb1);
        } else if (p == 4 || p == 6) {
            const bool gm = a.use_group != 0; const int gq = C.blk & 7;
            unsigned* ctr = gm ? (unsigned*)(ws + WS_CTL) + 13312 + 64 * (((2 * l + (p == 6 ? 1 : 0)) * 8) + gq) : (unsigned*)(ws + WS_CTL) + 64 * (2 * l + (p == 6 ? 1 : 0) + 4 * rep);
            const int n_ml = gm ? 128 : 1024, n_all = gm ? 192 : 1536;
            if (C.tid == 0) misc[0] = (int)atomicAdd(ctr, 1u);
            LBAR();
            int idx = misc[0];
            LBAR();
            while (idx < n_all) {
                unsigned nxt = 0u;
                if (C.tid == 0) nxt = atomicAdd(ctr, 1u);
                if (idx < n_ml) { const int item = gm ? gq * 128 + idx : idx; if (p == 4) mlstm_item<0>(C, a, l, item); else mlstm_item<1>(C, a, l, item); }
                else if (gm) { const int u2 = 2 * (idx - 128) + (p == 6 ? 1 : 0); sb_unit(C, big, mixo, gq, u2 & 7, 15 - (u2 >> 3)); }
                else { const int u2 = 2 * (idx - 1024) + (p == 6 ? 1 : 0); const int qb = 15 - (u2 >> 6), bh = u2 & 63; sb_unit(C, big, mixo, bh >> 3, bh & 7, qb); }
                if (C.tid == 0) misc[0] = (int)nxt;
                LBAR();
                idx = misc[0];
                LBAR();
            }
        } else if (p == 5) {
            mlstm_scan(C, a);
        } else if (p == 7) {
            pg8::Gemm g{mixo, (const bf16_t*)(ws + W_OUT), M, D, D}; pg8::StaticOrder S; S.init(M, D, C.G, C.blk);
            pg8::EpiResid<false, false> E{a.in[0], a.out, xb, ssb0, 1.0f, P};
            pg8::gemm_phase(C.lds, g, S, E);
        } else if (p == 8) {
            pg8::Gemm g{xb, (const bf16_t*)(ws + W_XQ), M, D, D}; pg8::StaticOrder S; S.init(M, D, C.G, C.blk);
            if ((M / 256) * (D / 256) == C.G) {
                EpiQXattn EQ{ssb0, a.in[18] + l * 256, P, C.lds, (const bf16_t*)(ws + WS_KV), ob, l};
                pg8::gemm_phase(C.lds, g, S, EQ);
            } else {
            pg8::EpiHeadNorm E{qn, D, ssb0, a.in[18] + l * 256, a.in[18] + l * 256, P, GX_Q / 2};
            pg8::gemm_phase(C.lds, g, S, E);
            asm volatile("s_waitcnt vmcnt(0)" ::: "memory"); __syncthreads();
            RELAUNDER();
            { pg8::Unit u; for (int i = 0; S.next(i, u); ++i) { const int b = u.pm >> 3, qb0 = (u.pm & 7) * 2;
                xattn_unit(C, qn, (const bf16_t*)(ws + WS_KV), ob, l, b, u.pn, qb0); xattn_unit(C, qn, (const bf16_t*)(ws + WS_KV), ob, l, b, u.pn, qb0 + 1); } }
            }
        } else if (p == 9) {
        } else if (p == 10) {
            pg8::Gemm g{ob, (const bf16_t*)(ws + W_XO), M, D, D, GX_Q}; pg8::StaticOrder S; S.init(M, D, C.G, C.blk);
            pg8::EpiResid<false, false> E{a.in[0], a.out, xb, ssb1, 1.0f, P};
            pg8::gemm_phase(C.lds, g, S, E);
        }
        if (it + 1 < hi && p != 9) {
            if (lo < 0) cg::this_grid().sync();
            const bool grp = a.use_group && p >= 1 && p <= 11;
            if (grp) {
                if (glocal < 0) glocal = (__builtin_popcount(xb_ld((unsigned*)(ws + WS_CTL) + CW_GMASK + (C.blk & 7))) == 1) ? 1 : 0;
                ++gk; unsigned* gctr = (unsigned*)(ws + WS_CTL) + CW_GRP + 64 * (C.blk & 7);
                if (glocal) group_barrier<false>(gctr, gk * gmembers); else group_barrier<true>(gctr, gk * gmembers);
            } else xcd_barrier(xbar);
        }
    }
}

#undef xb
#undef big
#undef mixo
#undef qn
#undef ob
#undef ssb0
#undef ssb1
extern "C" void kernel_launch(void* const* d_in, const int* in_sizes, int n_in, void* d_out, int out_size, void* d_ws, size_t ws_size, hipStream_t stream) {
    static int grid = 0;
    if (grid == 0) {
        if (n_in != 25 || out_size != M * D || ws_size < WS_END) { fprintf(stderr, "kernel_launch: unexpected problem (n_in %d out %d ws %zu)\n", n_in, out_size, ws_size); grid = -1; return; }
        int dev = 0, cus = 0, per_cu = 0;
        hipGetDevice(&dev); hipDeviceGetAttribute(&cus, hipDeviceAttributeMultiprocessorCount, dev);
        hipFuncSetAttribute((const void*)fwd_kernel, hipFuncAttributeMaxDynamicSharedMemorySize, LDS_BYTES);
        hipOccupancyMaxActiveBlocksPerMultiprocessor(&per_cu, (const void*)fwd_kernel, 512, LDS_BYTES);
        if (per_cu < 1) per_cu = 1;
        grid = cus * per_cu;
        (void)hipGetLastError();
        { const int shp[4][2] = {{M, NGU}, {M, NINP}, {M, D}, {MM, 4096}}; bool ok = true;
          for (int s = 0; s < 4 && ok; ++s) for (int c = 0; c < grid && ok; ++c) { pg8::StaticOrder S; S.init(shp[s][0], shp[s][1], grid, c); pg8::Unit u; int base = -1;
              for (int i = 0; S.next(i, u); ++i) { if (base < 0) base = (u.pm >> 3) << 3; if (u.pm < base || u.pm >= base + 8) ok = false; } }
          if (!ok) { fprintf(stderr, "kernel_launch: unit order does not keep a workgroup inside one 8-panel group on a %d-workgroup grid; nothing launched\n", grid); grid = -1; return; } }
    }
    if (grid < 0) return;
    if (hipMemsetAsync((char*)d_ws + WS_CTL, 0, CTL_ZERO_BYTES, stream) != hipSuccess) { fprintf(stderr, "kernel_launch: memset failed\n"); return; }
    static int use_group = -1;
    if (use_group < 0) {
        bool ok = (grid == 256);
        const int shp2[3] = {NGU, NINP, D};
        for (int s2 = 0; s2 < 3 && ok; ++s2) for (int c = 0; c < grid && ok; ++c) { pg8::StaticOrder S; S.init(M, shp2[s2], grid, c); pg8::Unit u;
            for (int i = 0; S.next(i, u); ++i) if ((u.pm >> 3) != (c & 7)) ok = false; }
        use_group = ok ? 1 : 0;
    }
    Args a{};
    a.use_group = use_group;
    for (int i = 0; i < 25; ++i) a.in[i] = (const float*)d_in[i];
    a.out = (float*)d_out; a.ws = (unsigned char*)d_ws;
#if MK_ONE
    a.ph_lo = 0; a.ph_hi = NPH + PROBE_DUP_N;
    void* args[] = {&a};
    hipError_t e = hipLaunchCooperativeKernel((const void*)fwd_kernel, dim3(grid), dim3(512), args, LDS_BYTES, stream);
    if (e != hipSuccess) fprintf(stderr, "cooperative launch failed: %s (grid %d)\n", hipGetErrorString(e), grid);
#else
#ifndef PH_LIMIT
#define PH_LIMIT NPH
#endif
    for (int ph = 0; ph < PH_LIMIT; ++ph) { a.ph_lo = ph; a.ph_hi = ph + 1; hipLaunchKernelGGL(fwd_kernel, dim3(grid), dim3(512), LDS_BYTES, stream, a); }
#endif
}
```

```cpp
#include <hip/hip_runtime.h>
#include <hip/hip_cooperative_groups.h>
#include <cstdio>
#include <cstdint>
namespace cg = cooperative_groups;

#ifndef MK_ONE
#define MK_ONE 1
#endif

#ifndef PH_MASK
#define PH_MASK 0x1ff
#endif
#define PH_ON(k) (((PH_MASK) >> (k)) & 1)
#define LAS __attribute__((address_space(3)))
typedef unsigned short bf16_t;
typedef short bf16x8 __attribute__((ext_vector_type(8)));
typedef float f32x4 __attribute__((ext_vector_type(4)));
typedef unsigned u32x4 __attribute__((ext_vector_type(4)));
typedef unsigned u32x2 __attribute__((ext_vector_type(2)));

constexpr int BATCH = 8, SEQ = 2048, D = 1024, M = BATCH * SEQ, FF = 2816, NGU = 2 * FF, NIN = 3592, NINP = 3584, MEML = 256, MM = BATCH * MEML;
constexpr float EPS = 1e-6f;
constexpr int NPH = 26;

constexpr size_t MiB = 1u << 20;
constexpr size_t WS_CTL = 0;
constexpr size_t WS_SS = 64 * 1024;
constexpr size_t WS_SSM = WS_SS + 2 * MiB;
constexpr size_t WS_GI = WS_SSM + 128 * 1024;
constexpr size_t WS_GF = WS_GI + 256 * 1024;
constexpr size_t WS_WG = WS_GF + 256 * 1024;
constexpr size_t WS_MLS = WS_WG + 64 * 1024;
constexpr size_t WS_WGB = WS_MLS + 16 * 1024;
constexpr size_t WS_W = 3 * MiB;
constexpr size_t W_GU1 = WS_W, W_D1 = W_GU1 + 11 * MiB, W_IN = W_D1 + 5 * MiB + 512 * 1024, W_OUT = W_IN + 7 * MiB, W_XQ = W_OUT + 2 * MiB, W_XO = W_XQ + 2 * MiB,
                 W_GU2 = W_XO + 2 * MiB, W_D2 = W_GU2 + 11 * MiB, W_END = W_D2 + 5 * MiB + 512 * 1024;
constexpr size_t WS_WKV = 49 * MiB;
constexpr size_t WS_XB = 57 * MiB;
constexpr size_t WS_BIG = 89 * MiB;
constexpr size_t GRP_STRIDE = 14 * MiB;
constexpr size_t GX_H = GRP_STRIDE - 2048 * (size_t)FF * 2, GX_Q = GRP_STRIDE - 2048 * (size_t)D * 2;
constexpr size_t WS_MIXO = 201 * MiB;
constexpr size_t WS_KV = 233 * MiB;
constexpr size_t WS_MEMB = 249 * MiB;
constexpr size_t WS_END = 254 * MiB;
static_assert(W_END == 49 * MiB, "weight map");

constexpr int RING_BYTES = 131072;
constexpr int XSCR_OFF = RING_BYTES;
constexpr int MISC_OFF = XSCR_OFF + 4096;
constexpr int RT_OFF = 139264;
constexpr int LDS_BYTES = 147456;

typedef float f32x2_t __attribute__((ext_vector_type(2)));
typedef __bf16 bf16x2_t __attribute__((ext_vector_type(2)));
__device__ __forceinline__ unsigned pk(float lo, float hi) { f32x2_t v = {lo, hi}; bf16x2_t b = __builtin_convertvector(v, bf16x2_t); return __builtin_bit_cast(unsigned, b); }
__device__ __forceinline__ float bflo(unsigned u) { return __uint_as_float(u << 16); }
__device__ __forceinline__ float bfhi(unsigned u) { return __uint_as_float(u & 0xffff0000u); }
__device__ __forceinline__ float fexp(float x) { return __builtin_amdgcn_exp2f(x * 1.4426950408889634f); }
__device__ __forceinline__ float flog(float x) { return __builtin_amdgcn_logf(x) * 0.6931471805599453f; }
__device__ __forceinline__ float frcp(float x) { return __builtin_amdgcn_rcpf(x); }
__device__ __forceinline__ float softplus(float z) { return fmaxf(z, 0.f) + flog(1.f + fexp(-fabsf(z))); }
__device__ __forceinline__ float sigmoidf_(float z) { return frcp(1.f + fexp(-z)); }
__device__ __forceinline__ float wave_sum(float v) {
#pragma unroll
    for (int o = 1; o < 64; o <<= 1) v += __shfl_xor(v, o);
    return v;
}
__device__ __forceinline__ f32x4 mfma16(bf16x8 a, bf16x8 b, f32x4 c) { return __builtin_amdgcn_mfma_f32_16x16x32_bf16(a, b, c, 0, 0, 0); }
__device__ __forceinline__ bf16x8 mk8(u32x2 a, u32x2 b) { u32x4 t; t.x = a.x; t.y = a.y; t.z = b.x; t.w = b.y; return __builtin_bit_cast(bf16x8, t); }
__device__ __forceinline__ bf16x8 mk8u(unsigned a, unsigned b, unsigned c, unsigned d) { u32x4 t; t.x = a; t.y = b; t.z = c; t.w = d; return __builtin_bit_cast(bf16x8, t); }
typedef short v4i16_t __attribute__((ext_vector_type(4)));
__device__ __forceinline__ u32x2 trd(const LAS bf16_t* p) { return __builtin_bit_cast(u32x2, __builtin_amdgcn_ds_read_tr16_b64_v4i16((LAS v4i16_t*)p)); }
__device__ __forceinline__ float rowscale(const float* ss, int row) {
    const f32x4 a = *(const f32x4*)(ss + (size_t)row * 4);
    return __builtin_amdgcn_rsqf(((a.x + a.y) + (a.z + a.w)) * (1.f / 1024.f) + EPS);
}
#define LDS_WAIT() asm volatile("s_waitcnt lgkmcnt(0)" ::: "memory")
#define WG_BAR() do { asm volatile("s_waitcnt vmcnt(0) lgkmcnt(0)" ::: "memory"); __builtin_amdgcn_s_barrier(); asm volatile("" ::: "memory"); } while (0)
#define LBAR() do { asm volatile("s_waitcnt lgkmcnt(0)" ::: "memory"); __builtin_amdgcn_s_barrier(); asm volatile("" ::: "memory"); } while (0)

namespace pg8 {
constexpr int BM = 256, BK = 64, HALF = 128, HTB = HALF * BK * 2, STAGE_BYTES = 8 * HTB, NXCD = 8, WGM = 8;
__host__ __device__ __forceinline__ int lds_byte(int r, int c) { const int st = (r >> 4) * 2 + (c >> 5), rr = r & 15, cc = c & 31, ob = rr * 64 + cc * 2; return st * 1024 + (ob ^ (((ob >> 9) & 1) << 5)); }
__host__ __device__ __forceinline__ void stage_rc(int b, int& R, int& C) { const int st = b / 1024, sb = b % 1024, swz = sb ^ (((sb >> 9) & 1) << 5); R = (st >> 1) * 16 + swz / 64; C = (st & 1) * 32 + (swz % 64) / 2; }
__host__ __device__ __forceinline__ int perm32(int rho) { const int n = rho >> 4, i = rho & 15; return 8 * (i >> 2) + 4 * n + (i & 3); }
struct Unit { int pm, pn; };
struct Gemm { const bf16_t* A; const bf16_t* Bt; int M, N, K; size_t gx = 0; };
struct StaticOrder {
    int nM, nN, nwg, G, c, direct_hb;
    __host__ __device__ void init(int M_, int N_, int G_, int c_) { nM = M_ / BM; nN = N_ / BM; nwg = nM * nN; G = G_; c = c_; direct_hb = -1; }
    __host__ __device__ bool next(int i, Unit& u) const {
        if (direct_hb >= 0) { if (i > 0 || c < direct_hb) return false; u.pm = c & 7; u.pn = (c - direct_hb) >> 3; return u.pn < nN && u.pm < nM; }
        const long L = (long)i * G + c; if (L >= nwg) return false;
        int wgid = (int)L; { const int q = nwg / NXCD, r = nwg % NXCD, xcd = wgid % NXCD, off = wgid / NXCD; wgid = (xcd < r ? xcd * (q + 1) : r * (q + 1) + (xcd - r) * q) + off; }
        const int nig = WGM * nN, gid = wgid / nig, fm = gid * WGM, gsz = (nM - fm) < WGM ? (nM - fm) : WGM;
        u.pm = fm + ((wgid % nig) % gsz); u.pn = (wgid % nig) / gsz; return true;
    }
};
typedef f32x4 Acc[2][2][4][2];

struct RowTab { const LAS float* rt; int base_pm; };
__device__ __forceinline__ float rs_get(const RowTab& T, const float* ss, const Unit& u, int rl) {
    return T.rt[((u.pm - T.base_pm) & 7) * BM + rl];
}
struct EpiSwiglu {
    static constexpr bool USE_RT = true, AFTER_DRAIN = false;
    bf16_t* H; const float* ss;
    __device__ __forceinline__ void operator()(const Acc& acc, const Unit& u, int wr, int wc, int fr, int fq, const RowTab& T) const {
        const int row0 = u.pm * BM + wr * 64 + fr, col0 = u.pn * HALF + wc * 32 + 8 * fq;
#pragma unroll
        for (int ai = 0; ai < 2; ++ai)
#pragma unroll
            for (int m = 0; m < 4; ++m) {
                const int row = row0 + ai * HALF + m * 16; const float r = rs_get(T, ss, u, ai * HALF + wr * 64 + m * 16 + fr);
                const float rs_ = r * -1.4426950408889634f, r2 = r * r;
                float hv[8];
#pragma unroll
                for (int n = 0; n < 2; ++n)
#pragma unroll
                    for (int e = 0; e < 4; ++e) { const float g = acc[ai][0][m][n][e], up = acc[ai][1][m][n][e]; hv[4 * n + e] = (g * up) * (r2 * frcp(1.f + __builtin_amdgcn_exp2f(g * rs_))); }
                u32x4 w; w.x = pk(hv[0], hv[1]); w.y = pk(hv[2], hv[3]); w.z = pk(hv[4], hv[5]); w.w = pk(hv[6], hv[7]);
                *(u32x4*)(H + (size_t)row * FF + (size_t)(u.pm >> 3) * (GX_H / 2) + col0) = w;
            }
    }
};
template <bool IN_F32, bool OUT_F32>
struct EpiResid {
    static constexpr bool USE_RT = false, AFTER_DRAIN = false; static constexpr const float* ss = nullptr;
    const float* xin; float* xout; bf16_t* xb; float* ssout; float alpha; LAS float* P;
    __device__ __forceinline__ void operator()(const Acc& acc, const Unit& u, int wr, int wc, int fr, int fq, const RowTab& T) const {
        const int row0 = u.pm * BM + wr * 64 + fr, col0 = u.pn * BM + wc * 32 + 8 * fq;
#pragma unroll
        for (int ai = 0; ai < 2; ++ai) {
            u32x4 xh[4][2];
            if (!IN_F32) {
#pragma unroll
                for (int m = 0; m < 4; ++m)
#pragma unroll
                    for (int bj = 0; bj < 2; ++bj) xh[m][bj] = *(const u32x4*)(xb + (size_t)(row0 + ai * HALF + m * 16) * D + col0 + bj * HALF);
            }
            f32x4 xv[4][2][2];
            if (IN_F32) {
#pragma unroll
                for (int m = 0; m < 4; ++m)
#pragma unroll
                    for (int bj = 0; bj < 2; ++bj) { const size_t off = (size_t)(row0 + ai * HALF + m * 16) * D + col0 + bj * HALF; xv[m][bj][0] = *(const f32x4*)(xin + off); xv[m][bj][1] = *(const f32x4*)(xin + off + 4); }
            }
#pragma unroll
            for (int m = 0; m < 4; ++m) {
                const int row = row0 + ai * HALF + m * 16; float sq = 0.f;
#pragma unroll
                for (int bj = 0; bj < 2; ++bj) {
                    const size_t off = (size_t)row * D + col0 + bj * HALF;
                    f32x4 x0, x1;
                    if (IN_F32) { x0 = xv[m][bj][0]; x1 = xv[m][bj][1]; }
                    else { const u32x4 h = xh[m][bj]; x0 = (f32x4){bflo(h.x), bfhi(h.x), bflo(h.y), bfhi(h.y)}; x1 = (f32x4){bflo(h.z), bfhi(h.z), bflo(h.w), bfhi(h.w)}; }
                    const f32x4 a = x0 + acc[ai][bj][m][0] * alpha, b = x1 + acc[ai][bj][m][1] * alpha;
                    if (OUT_F32) { *(f32x4*)(xout + off) = a; *(f32x4*)(xout + off + 4) = b; }
                    sq += (a.x * a.x + a.y * a.y) + (a.z * a.z + a.w * a.w) + (b.x * b.x + b.y * b.y) + (b.z * b.z + b.w * b.w);
                    if (!OUT_F32) { u32x4 w; w.x = pk(a.x, a.y); w.y = pk(a.z, a.w); w.z = pk(b.x, b.y); w.w = pk(b.z, b.w); *(u32x4*)(xb + off) = w; }
                }
                if (!OUT_F32) { sq += __shfl_xor(sq, 16); sq += __shfl_xor(sq, 32);
                    if (fq == 0) P[(ai * HALF + wr * 64 + m * 16 + fr) * 4 + wc] = sq; }
            }
            asm volatile("" ::: "memory");
        }
        LBAR();
        if (!OUT_F32 && threadIdx.x < 256) { const f32x4 p = *(const LAS f32x4*)(P + threadIdx.x * 4); ssout[(size_t)(u.pm * BM + threadIdx.x) * 4 + u.pn] = (p.x + p.y) + (p.z + p.w); }
    }
};
struct EpiProj {
    static constexpr bool USE_RT = true, AFTER_DRAIN = false;
    bf16_t* O; int ldc; const float* ss;
    __device__ __forceinline__ void operator()(const Acc& acc, const Unit& u, int wr, int wc, int fr, int fq, const RowTab& T) const {
        const int row0 = u.pm * BM + wr * 64 + fr, col0 = u.pn * BM + wc * 32 + 8 * fq;
#pragma unroll
        for (int ai = 0; ai < 2; ++ai)
#pragma unroll
            for (int m = 0; m < 4; ++m) {
                const int row = row0 + ai * HALF + m * 16; const float r = rs_get(T, ss, u, ai * HALF + wr * 64 + m * 16 + fr);
#pragma unroll
                for (int bj = 0; bj < 2; ++bj) {
                    const f32x4 a = acc[ai][bj][m][0] * r, b = acc[ai][bj][m][1] * r;
                    u32x4 w; w.x = pk(a.x, a.y); w.y = pk(a.z, a.w); w.z = pk(b.x, b.y); w.w = pk(b.z, b.w);
                    *(u32x4*)(O + (size_t)row * ldc + col0 + bj * HALF) = w;
                }
            }
    }
};
struct EpiHeadNorm {
    static constexpr bool USE_RT = true, AFTER_DRAIN = false;
    bf16_t* O; int ldc; const float* ss; const float* gain0; const float* gain1; LAS float* P; size_t gxo;
    __device__ __forceinline__ void operator()(const Acc& acc, const Unit& u, int wr, int wc, int fr, int fq, const RowTab& T) const {
        const int row0 = u.pm * BM + wr * 64 + fr, col0 = u.pn * BM + wc * 32 + 8 * fq;
        const bool normed = ((u.pn >> 2) & 1) == 0; const float* gain = (u.pn >= 8) ? gain1 : gain0;
        float rs[2][4];
#pragma unroll
        for (int ai = 0; ai < 2; ++ai)
#pragma unroll
            for (int m = 0; m < 4; ++m) {
                const float r = rs_get(T, ss, u, ai * HALF + wr * 64 + m * 16 + fr); rs[ai][m] = r; float sq = 0.f;
#pragma unroll
                for (int bj = 0; bj < 2; ++bj)
#pragma unroll
                    for (int n = 0; n < 2; ++n) { const f32x4 v = acc[ai][bj][m][n] * r; sq += (v.x * v.x + v.y * v.y) + (v.z * v.z + v.w * v.w); }
                sq += __shfl_xor(sq, 16); sq += __shfl_xor(sq, 32);
                if (fq == 0) P[(ai * HALF + wr * 64 + m * 16 + fr) * 4 + wc] = sq;
            }
        LBAR();
        f32x4 g[2][2];
#pragma unroll
        for (int bj = 0; bj < 2; ++bj)
#pragma unroll
            for (int n = 0; n < 2; ++n) g[bj][n] = normed ? *(const f32x4*)(gain + bj * HALF + wc * 32 + 8 * fq + 4 * n) : (f32x4){1.f, 1.f, 1.f, 1.f};
#pragma unroll
        for (int ai = 0; ai < 2; ++ai)
#pragma unroll
            for (int m = 0; m < 4; ++m) {
                const int rl = ai * HALF + wr * 64 + m * 16 + fr; const f32x4 p = *(const LAS f32x4*)(P + rl * 4);
                const float tot = (p.x + p.y) + (p.z + p.w); const float rn = rs[ai][m] * (normed ? __builtin_amdgcn_rsqf(tot * (1.f / 256.f) + EPS) : 1.f);
                const int row = row0 + ai * HALF + m * 16;
#pragma unroll
                for (int bj = 0; bj < 2; ++bj) {
                    const f32x4 a = acc[ai][bj][m][0] * rn * g[bj][0], b = acc[ai][bj][m][1] * rn * g[bj][1];
                    u32x4 w; w.x = pk(a.x, a.y); w.y = pk(a.z, a.w); w.z = pk(b.x, b.y); w.w = pk(b.z, b.w);
                    *(u32x4*)(O + (size_t)row * ldc + (size_t)(u.pm >> 3) * gxo + col0 + bj * HALF) = w;
                }
            }
    }
};

template <class Epi>
__device__ __forceinline__ void gemm_phase(LAS unsigned char* lds, const Gemm g, const StaticOrder& S, const Epi& E) {
    int tid = threadIdx.x; asm volatile("" : "+v"(tid));
    const int wid = __builtin_amdgcn_readfirstlane(tid >> 6), lane = tid & 63, wr = wid >> 2, wc = wid & 3, fr = lane & 15, fq = lane >> 4;
    const int K = g.K, nt = K / BK;
    unsigned voffA[2], voffB[2];
#pragma unroll
    for (int i = 0; i < 2; ++i) { int R, C; stage_rc(tid * 16 + i * 8192, R, C); const int Rb = (R & ~31) + perm32(R & 31);
        voffA[i] = (unsigned)(R * K + C) * 2u; voffB[i] = (unsigned)(Rb * K + C) * 2u; }
    const size_t kstep = (size_t)(BK * 2);
    const size_t hstep = (size_t)HALF * K * 2;
    const size_t tstep = 2 * hstep;
    const unsigned ldsw = (unsigned)wid * 1024u;
    const int aoff = lds_byte(wr * 64 + fr, fq * 8), boff = lds_byte(wc * 32 + fr, fq * 8);
#define PG8_SA(b, h) (((b) * 2 + (h)) * HTB)
#define PG8_SB(b, h) ((4 + (b) * 2 + (h)) * HTB)
#define PG8_STAGE(bufoff, gbase, voff) do { _Pragma("unroll") for (int _i = 0; _i < 2; ++_i) \
        __builtin_amdgcn_global_load_lds((const unsigned*)((const char*)(gbase) + (voff)[_i]), (LAS unsigned*)(lds + (bufoff) + ldsw + _i * 8192), 16, 0, 0); } while (0)
#define PG8_LDA(dst, b, h) do { _Pragma("unroll") for (int m = 0; m < 4; ++m) _Pragma("unroll") for (int k = 0; k < 2; ++k) dst[m][k] = *(const LAS bf16x8*)(lds + PG8_SA(b, h) + aoff + m * 2048 + k * 1024); } while (0)
#define PG8_LDB(dst, b, h) do { _Pragma("unroll") for (int n = 0; n < 2; ++n) _Pragma("unroll") for (int k = 0; k < 2; ++k) dst[n][k] = *(const LAS bf16x8*)(lds + PG8_SB(b, h) + boff + n * 2048 + k * 1024); } while (0)
#define PG8_MMA(ai, bj, At, Bt) do { __builtin_amdgcn_s_setprio(1); _Pragma("unroll") for (int m = 0; m < 4; ++m) _Pragma("unroll") for (int n = 0; n < 2; ++n) _Pragma("unroll") for (int k = 0; k < 2; ++k) \
        acc[ai][bj][m][n] = __builtin_amdgcn_mfma_f32_16x16x32_bf16(Bt[n][k], At[m][k], acc[ai][bj][m][n], 0, 0, 0); __builtin_amdgcn_s_setprio(0); } while (0)
#define PG8_WAIT_V(n) asm volatile("s_waitcnt vmcnt(" #n ")" ::: "memory")
#define PG8_WAIT_L(n) asm volatile("s_waitcnt lgkmcnt(" #n ")" ::: "memory")
#define PG8_BAR __builtin_amdgcn_s_barrier()
#define PG8_SCHED __builtin_amdgcn_sched_barrier(0)
    Unit cur, nxt; int ui = 0;
    if (!S.next(0, cur)) return;
    RowTab T; T.rt = (const LAS float*)(lds + RT_OFF); T.base_pm = (cur.pm >> 3) << 3;
    f32x4 rtv[4];
    if constexpr (Epi::USE_RT) {
#pragma unroll
        for (int j = 0; j < 4; ++j) { const int row = T.base_pm * BM + tid + 512 * j; rtv[j] = (row < g.M) ? *(const f32x4*)(E.ss + (size_t)row * 4) : (f32x4){1.f, 1.f, 1.f, 1.f}; }
    }
    Acc acc;
#pragma unroll
    for (int a = 0; a < 2; ++a)
#pragma unroll
        for (int b = 0; b < 2; ++b)
#pragma unroll
            for (int m = 0; m < 4; ++m)
#pragma unroll
                for (int n = 0; n < 2; ++n) acc[a][b][m][n] = (f32x4){0.f, 0.f, 0.f, 0.f};
    bf16x8 At[4][2], B0[2][2], B1[2][2];
    const char* cA = (const char*)g.A + (size_t)cur.pm * tstep + (size_t)(cur.pm >> 3) * g.gx; const char* cB = (const char*)g.Bt + (size_t)cur.pn * tstep;
    PG8_STAGE(PG8_SB(0, 0), cB, voffB); PG8_STAGE(PG8_SB(0, 1), cB + hstep, voffB); PG8_STAGE(PG8_SA(0, 0), cA, voffA); PG8_STAGE(PG8_SA(0, 1), cA + hstep, voffA);
    if constexpr (Epi::USE_RT) {
        LAS float* rtw = (LAS float*)(lds + RT_OFF);
#pragma unroll
        for (int j = 0; j < 4; ++j) rtw[tid + 512 * j] = __builtin_amdgcn_rsqf(((rtv[j].x + rtv[j].y) + (rtv[j].z + rtv[j].w)) * (1.f / 1024.f) + EPS);
        asm volatile("s_waitcnt lgkmcnt(0)" ::: "memory");
    }
    if (wr == 1) PG8_BAR;
    PG8_WAIT_V(2); PG8_BAR;
    PG8_STAGE(PG8_SB(1, 0), cB + kstep, voffB); PG8_STAGE(PG8_SA(1, 0), cA + kstep, voffA); PG8_STAGE(PG8_SB(1, 1), cB + hstep + kstep, voffB);
    PG8_WAIT_V(6); PG8_BAR;
    for (;;) {
        const bool has_next = S.next(ui + 1, nxt);
        const char* nA = has_next ? (const char*)g.A + (size_t)nxt.pm * tstep + (size_t)(nxt.pm >> 3) * g.gx : cA; const char* nB = has_next ? (const char*)g.Bt + (size_t)nxt.pn * tstep : cB;
        for (int t = 0; t < nt; t += 2) {
            const bool last = (t == nt - 2);
            const char* a1 = cA + (size_t)(t + 1) * kstep;
            const char* a2 = last ? nA : cA + (size_t)(t + 2) * kstep; const char* b2 = last ? nB : cB + (size_t)(t + 2) * kstep;
            const char* a3 = a2 + kstep; const char* b3 = b2 + kstep;
            PG8_LDB(B0, 0, 0); PG8_LDB(B1, 0, 1); PG8_SCHED; PG8_LDA(At, 0, 0); PG8_STAGE(PG8_SA(1, 1), a1 + hstep, voffA);
            PG8_WAIT_V(8); PG8_WAIT_L(0); PG8_BAR; PG8_MMA(0, 0, At, B0); PG8_MMA(0, 1, At, B1); PG8_BAR; PG8_SCHED;
            PG8_LDA(At, 0, 1); PG8_STAGE(PG8_SB(0, 0), b2, voffB); PG8_STAGE(PG8_SB(0, 1), b2 + hstep, voffB); PG8_STAGE(PG8_SA(0, 0), a2, voffA);
            PG8_WAIT_V(8); PG8_WAIT_L(0); PG8_BAR; PG8_MMA(1, 0, At, B0); PG8_MMA(1, 1, At, B1); PG8_BAR; PG8_SCHED;
            PG8_LDB(B0, 1, 0); PG8_LDB(B1, 1, 1); PG8_SCHED; PG8_LDA(At, 1, 0); PG8_STAGE(PG8_SA(0, 1), a2 + hstep, voffA);
            PG8_WAIT_V(8); PG8_WAIT_L(0); PG8_BAR; PG8_MMA(0, 0, At, B0); PG8_MMA(0, 1, At, B1); PG8_BAR; PG8_SCHED;
            PG8_LDA(At, 1, 1); PG8_STAGE(PG8_SB(1, 0), b3, voffB); PG8_STAGE(PG8_SB(1, 1), b3 + hstep, voffB); PG8_STAGE(PG8_SA(1, 0), a3, voffA);
            PG8_WAIT_V(8); PG8_WAIT_L(0); PG8_BAR; PG8_MMA(1, 0, At, B0); PG8_MMA(1, 1, At, B1); PG8_BAR; PG8_SCHED;
        }
        if (wr == 0) PG8_BAR;
        if constexpr (!Epi::AFTER_DRAIN) E(acc, cur, wr, wc, fr, fq, T);
        if (!has_next) break;
#pragma unroll
        for (int a = 0; a < 2; ++a)
#pragma unroll
            for (int b = 0; b < 2; ++b)
#pragma unroll
                for (int m = 0; m < 4; ++m)
#pragma unroll
                    for (int n = 0; n < 2; ++n) acc[a][b][m][n] = (f32x4){0.f, 0.f, 0.f, 0.f};
        cur = nxt; cA = nA; cB = nB; ++ui;
        if (wr == 1) PG8_BAR;
    }
    PG8_WAIT_V(0);
    PG8_BAR;
    if constexpr (Epi::AFTER_DRAIN) E(acc, cur, wr, wc, fr, fq, T);
#undef PG8_SA
#undef PG8_SB
#undef PG8_STAGE
#undef PG8_LDA
#undef PG8_LDB
#undef PG8_MMA
#undef PG8_WAIT_V
#undef PG8_WAIT_L
#undef PG8_BAR
#undef PG8_SCHED
}
}

struct Args { const float* in[25]; float* out; unsigned char* ws; int ph_lo, ph_hi, use_group, pad; };

struct Ctx {
    LAS unsigned char* lds; int tid, lane, wave, G, blk;
};

__device__ __forceinline__ void tr_item(const float* W, int ldw, const float* g, int K, bf16_t* dst, int k0, int n0, int drow0, LAS float* scr, int lane) {
    { f32x4 v[8]; const int c4 = (lane & 7) * 4;
#pragma unroll
      for (int i = 0; i < 8; ++i) { const int kk = (lane >> 3) + 8 * i; v[i] = *(const f32x4*)(W + (size_t)(k0 + kk) * ldw + n0 + c4); }
#pragma unroll
      for (int i = 0; i < 8; ++i) { const int kk = (lane >> 3) + 8 * i; f32x4 t = v[i]; if (g) t = t * g[k0 + kk];
          LAS float* d = scr + kk * 33 + c4; d[0] = t.x; d[1] = t.y; d[2] = t.z; d[3] = t.w; } }
    LDS_WAIT(); asm volatile("" ::: "memory");
    const int c = lane & 7;
#pragma unroll
    for (int j = 0; j < 4; ++j) { const int n = (lane >> 3) + 8 * j; const LAS float* s = scr + (8 * c) * 33 + n;
        u32x4 o; o.x = pk(s[0 * 33], s[1 * 33]); o.y = pk(s[2 * 33], s[3 * 33]); o.z = pk(s[4 * 33], s[5 * 33]); o.w = pk(s[6 * 33], s[7 * 33]);
        *(u32x4*)(dst + (size_t)(drow0 + n) * K + k0 + 8 * c) = o; }
    LDS_WAIT(); asm volatile("" ::: "memory");
}
__device__ __forceinline__ void tr_plain(const float* W, int ldw, const float* g, int K, int N, bf16_t* dst, int drow_off, int item, LAS float* scr, int lane) {
    const int nnb = N / 32, kb = item / nnb, nb = item % nnb; tr_item(W, ldw, g, K, dst, kb * 64, nb * 32, drow_off + nb * 32, scr, lane);
}
__device__ __forceinline__ void tr_gu(const float* W, const float* g, bf16_t* dst, int upoff, int item, LAS float* scr, int lane) {
    const int nnb = FF / 32, kb = item / nnb, nb = item % nnb, n0 = nb * 32; tr_item(W, FF, g, D, dst, kb * 64, n0, (n0 >> 7) * 256 + (n0 & 127) + upoff, scr, lane);
}
__device__ __forceinline__ void conv_phase(const Ctx& C, const Args& a, int l) {
    LAS float* scr = (LAS float*)(C.lds + C.wave * 16384);
    unsigned char* ws = a.ws;
    const int gw = C.blk * 8 + C.wave, NGW = C.G * 8, lane = C.lane;
    constexpr int I_GU = 16 * 88, I_DN = 44 * 32, I_IN = 16 * 112, I_SQ = 16 * 32;
    const int n_layer = 6 * I_GU + I_IN + 3 * I_SQ;
    const int n_items = n_layer + (l == 0 ? 4 * I_SQ : 0);
    for (int it = gw; it < n_items; it += NGW) {
        int r = it;
        if (r < I_GU) { tr_gu(a.in[3] + (size_t)l * D * FF, a.in[2] + l * D, (bf16_t*)(ws + W_GU1), 0, r, scr, lane); continue; } r -= I_GU;
        if (r < I_GU) { tr_gu(a.in[4] + (size_t)l * D * FF, a.in[2] + l * D, (bf16_t*)(ws + W_GU1), 128, r, scr, lane); continue; } r -= I_GU;
        if (r < I_DN) { tr_plain(a.in[5] + (size_t)l * FF * D, D, nullptr, FF, D, (bf16_t*)(ws + W_D1), 0, r, scr, lane); continue; } r -= I_DN;
        if (r < I_GU) { tr_gu(a.in[22] + (size_t)l * D * FF, a.in[21] + l * D, (bf16_t*)(ws + W_GU2), 0, r, scr, lane); continue; } r -= I_GU;
        if (r < I_GU) { tr_gu(a.in[23] + (size_t)l * D * FF, a.in[21] + l * D, (bf16_t*)(ws + W_GU2), 128, r, scr, lane); continue; } r -= I_GU;
        if (r < I_DN) { tr_plain(a.in[24] + (size_t)l * FF * D, D, nullptr, FF, D, (bf16_t*)(ws + W_D2), 0, r, scr, lane); continue; } r -= I_DN;
        if (r < I_IN) { tr_plain(a.in[7] + (size_t)l * D * NIN, NIN, a.in[6] + l * D, D, NINP, (bf16_t*)(ws + W_IN), 0, r, scr, lane); continue; } r -= I_IN;
        if (r < I_SQ) { tr_plain(a.in[12] + (size_t)l * D * D, D, nullptr, D, D, (bf16_t*)(ws + W_OUT), 0, r, scr, lane); continue; } r -= I_SQ;
        if (r < I_SQ) { tr_plain(a.in[15] + (size_t)l * D * D, D, a.in[13] + l * D, D, D, (bf16_t*)(ws + W_XQ), 0, r, scr, lane); continue; } r -= I_SQ;
        if (r < I_SQ) { tr_plain(a.in[20] + (size_t)l * D * D, D, nullptr, D, D, (bf16_t*)(ws + W_XO), 0, r, scr, lane); continue; } r -= I_SQ;
        { const int which = r / I_SQ, rr = r % I_SQ, ll = which >> 1, kv = which & 1;
          tr_plain(a.in[kv ? 17 : 16] + (size_t)ll * D * D, D, a.in[14] + ll * D, D, D, (bf16_t*)(ws + WS_WKV), ll * 2048 + kv * 1024, rr, scr, lane); }
    }
    if (l == 0) {
        float* ss0 = (float*)(ws + WS_SS); float* ssm = (float*)(ws + WS_SSM);
        for (int m0 = gw; m0 < M + MM; m0 += 2 * NGW) {
            f32x4 v[2][4]; float sq[2];
#pragma unroll
            for (int u = 0; u < 2; ++u) { const int m = m0 + u * NGW; if (m < M + MM) { const bool isx = m < M; const int row = isx ? m : m - M;
                const f32x4* xr = (const f32x4*)((isx ? a.in[0] : a.in[1]) + (size_t)row * D) + lane;
#pragma unroll
                for (int j = 0; j < 4; ++j) v[u][j] = xr[64 * j]; } }
#pragma unroll
            for (int u = 0; u < 2; ++u) { const int m = m0 + u * NGW; if (m < M + MM) { const bool isx = m < M; const int row = isx ? m : m - M;
                bf16_t* dst = (bf16_t*)(ws + (isx ? WS_XB : WS_MEMB)) + (size_t)row * D; float s = 0.f;
#pragma unroll
                for (int j = 0; j < 4; ++j) s += (v[u][j].x * v[u][j].x + v[u][j].y * v[u][j].y) + (v[u][j].z * v[u][j].z + v[u][j].w * v[u][j].w);
                s = wave_sum(s); sq[u] = s;
#pragma unroll
                for (int j = 0; j < 4; ++j) { u32x2 w; w.x = pk(v[u][j].x, v[u][j].y); w.y = pk(v[u][j].z, v[u][j].w); *((u32x2*)dst + lane + 64 * j) = w; }
                if (lane < 4) (isx ? ss0 : ssm)[(size_t)row * 4 + lane] = (lane == 0) ? sq[u] : 0.f; } }
        }
        bf16_t* wgb = (bf16_t*)(ws + WS_WGB);
        for (int idx = C.blk * 512 + C.tid; idx < 2 * 16 * 512; idx += C.G * 512) {
            const int ll = idx >> 13, j = (idx >> 9) & 15, k = (idx & 511) * 2;
            float w0 = 0.f, w1 = 0.f;
            if (j < 8) { w0 = a.in[6][ll * D + k] * a.in[7][(size_t)ll * D * NIN + (size_t)k * NIN + NINP + j]; w1 = a.in[6][ll * D + k + 1] * a.in[7][(size_t)ll * D * NIN + (size_t)(k + 1) * NIN + NINP + j]; }
            ((unsigned*)wgb)[idx] = pk(w0, w1);
        }
        if (C.blk == 0 && C.tid < 64) ((unsigned*)(ws + WS_CTL))[C.tid * 64] = 0u;
    }
}

__device__ __forceinline__ void gates_pass(const Ctx& C, const Args& a, int l, const float* ss) {
    const int hb = C.G / 2;
    if (C.blk < hb) return;
    unsigned char* ws = a.ws;
    const bf16_t* xbp = (const bf16_t*)(ws + WS_XB); const bf16_t* wgb = (const bf16_t*)(ws + WS_WGB) + (size_t)l * 16 * 1024;
    float* gi = (float*)(ws + WS_GI); float* gf = (float*)(ws + WS_GF);
    const float* bg = a.in[8] + l * 8;
    const int lane = C.lane, fr = lane & 15, fq = lane >> 4;
    const bool grp = a.use_group != 0;
    const int gw = grp ? (((C.blk - hb) >> 3) * 8 + C.wave) : ((C.blk - hb) * 8 + C.wave), NGW = grp ? ((((C.G - hb) + 7) >> 3) * 8) : ((C.G - hb) * 8);
    const int tbase = grp ? (C.blk & 7) * (SEQ / 16) : 0, tend = grp ? tbase + SEQ / 16 : M / 16;
    for (int task = tbase + gw; task < tend; task += NGW) {
        const int row0 = task * 16;
        const bf16_t* ap = xbp + (size_t)(row0 + fr) * D + 8 * fq; const bf16_t* bp = wgb + fr * 1024 + 8 * fq;
        f32x4 acc = (f32x4){0.f, 0.f, 0.f, 0.f};
#pragma unroll 8
        for (int kk = 0; kk < 32; ++kk) acc = mfma16(*(const bf16x8*)(ap + 32 * kk), *(const bf16x8*)(bp + 32 * kk), acc);
        if (fr < 8) {
            const int r0 = row0 + 4 * fq, b = r0 >> 11, s = r0 & 2047, h = fr & 3; const float bias = bg[fr];
            f32x4 o;
#pragma unroll
            for (int e = 0; e < 4; ++e) { const float pre = acc[e] * rowscale(ss, r0 + e) + bias; o[e] = (fr < 4) ? pre : fminf(pre, 0.f) - flog(1.f + fexp(-fabsf(pre))); }
            *(f32x4*)((fr < 4 ? gi : gf) + (size_t)(b * 4 + h) * SEQ + s) = o;
        }
    }
}

constexpr int SB_KS = 72;
constexpr int SB_BUF = 2 * 64 * SB_KS * 2;
template <bool MASKED>
__device__ __forceinline__ void sb_tile(const LAS bf16_t* Ks, const LAS bf16_t* Vs, int k0, int tq, int fr, int fq, const bf16x8 (&qf)[2],
                                        const bf16x8 UA, const bf16x8 UB, const bf16x8 ONES, f32x4 (&oacc)[4], float& carry) {
    f32x4 z[4];
#pragma unroll
    for (int i = 0; i < 4; ++i) {
        z[i] = (f32x4){0.f, 0.f, 0.f, 0.f};
#pragma unroll
        for (int kk = 0; kk < 2; ++kk) { const bf16x8 kf = *(const LAS bf16x8*)(Ks + (16 * i + fr) * SB_KS + 32 * kk + 8 * fq); z[i] = mfma16(kf, qf[kk], z[i]); }
    }
    float Lv[4][4], zl[4][4];
    const int lim = tq - k0 - 4 * fq;
#pragma unroll
    for (int i = 0; i < 4; ++i)
#pragma unroll
        for (int e = 0; e < 4; ++e) {
            float zz = z[i][e] * 0.18033688011112042f;
            if (MASKED) zz = (16 * i + e < lim) ? zz : -1e30f;
            const float sp = fmaxf(zz, 0.f) + __builtin_amdgcn_logf(1.f + __builtin_amdgcn_exp2f(-fabsf(zz)));
            Lv[i][e] = -sp; zl[i][e] = zz - sp;
        }
    bf16x8 hi[2];
#pragma unroll
    for (int kk = 0; kk < 2; ++kk) hi[kk] = mk8u(pk(Lv[2 * kk][0], Lv[2 * kk][1]), pk(Lv[2 * kk][2], Lv[2 * kk][3]), pk(Lv[2 * kk + 1][0], Lv[2 * kk + 1][1]), pk(Lv[2 * kk + 1][2], Lv[2 * kk + 1][3]));
    f32x4 tot = (f32x4){0.f, 0.f, 0.f, 0.f};
#pragma unroll
    for (int kk = 0; kk < 2; ++kk) tot = mfma16(ONES, hi[kk], tot);
    unsigned pw[2][4];
#pragma unroll
    for (int io = 0; io < 4; ++io) {
        f32x4 lt = (f32x4){carry, carry, carry, carry};
        { const bf16x8 ud = (io & 1) ? UB : UA; lt = mfma16(ud, hi[io >> 1], lt); }
        if (io < 2) lt = mfma16(ONES, hi[1], lt);
        float av[4];
#pragma unroll
        for (int e = 0; e < 4; ++e) av[e] = __builtin_amdgcn_exp2f(zl[io][e] + lt[e]);
        pw[io >> 1][(io & 1) * 2 + 0] = pk(av[0], av[1]); pw[io >> 1][(io & 1) * 2 + 1] = pk(av[2], av[3]);
    }
    const bf16x8 P0 = mk8u(pw[0][0], pw[0][1], pw[0][2], pw[0][3]), P1 = mk8u(pw[1][0], pw[1][1], pw[1][2], pw[1][3]);
#pragma unroll
    for (int dt = 0; dt < 4; ++dt) {
        const LAS bf16_t* vr = Vs + (4 * fq + (fr >> 2)) * SB_KS + 16 * dt + 4 * (fr & 3);
        const bf16x8 v0 = mk8(trd(vr), trd(vr + 16 * SB_KS)), v1 = mk8(trd(vr + 32 * SB_KS), trd(vr + 48 * SB_KS));
        oacc[dt] = mfma16(v0, P0, oacc[dt]); oacc[dt] = mfma16(v1, P1, oacc[dt]);
    }
    carry += tot[0];
}
__device__ __forceinline__ void sb_unit(const Ctx& C, const bf16_t* proj, bf16_t* mixo, int b, int h, int qb) {
    const int tid = C.tid, lane = C.lane, wid = C.wave, fr = lane & 15, fq = lane >> 4;
    const int q0 = qb * 128, tq = q0 + wid * 16 + fr;
    const size_t rowbase = (size_t)b * SEQ;
    bf16x8 qf[2];
    { const bf16_t* qp = proj + (rowbase + tq) * NINP + h * 64 + 8 * fq; qf[0] = *(const bf16x8*)qp; qf[1] = *(const bf16x8*)(qp + 32); }
    unsigned dg0, dg1;
    { const int d = fr - 4 * fq; dg0 = (0 > d ? 0x3F80u : 0u) | (1 > d ? 0x3F800000u : 0u); dg1 = (2 > d ? 0x3F80u : 0u) | (3 > d ? 0x3F800000u : 0u); }
    const bf16x8 UA = mk8u(dg0, dg1, 0x3F803F80u, 0x3F803F80u), UB = mk8u(0u, 0u, dg0, dg1);
    const bf16x8 ONES = mk8u(0x3F803F80u, 0x3F803F80u, 0x3F803F80u, 0x3F803F80u);
    f32x4 oacc[4];
#pragma unroll
    for (int i = 0; i < 4; ++i) oacc[i] = (f32x4){0.f, 0.f, 0.f, 0.f};
    float carry = 0.f;
    const int jt_max = 2 * qb + 1;
    const int ss_ = tid >> 3, sc_ = tid & 7;
    const bf16_t* kvp = proj + (rowbase + ss_) * NINP + h * 64 + 8 * sc_;
    u32x4 kreg, vreg;
    { const bf16_t* p = kvp + (size_t)(jt_max * 64) * NINP; kreg = *(const u32x4*)(p + 512); vreg = *(const u32x4*)(p + 1024); }
    int cur = 0;
    volatile LAS int* dflag = (volatile LAS int*)(C.lds + MISC_OFF) + 16;
    if (lane == 0) { dflag[wid] = 0; dflag[8 + wid] = 0; }
    int par = 0;
    for (int jt = jt_max; jt >= 0; --jt) {
        LAS unsigned char* buf = C.lds + cur * SB_BUF;
        LAS bf16_t* Ks = (LAS bf16_t*)buf; LAS bf16_t* Vs = (LAS bf16_t*)(buf + 64 * SB_KS * 2);
        *(LAS u32x4*)(Ks + ss_ * SB_KS + 8 * sc_) = kreg;
        *(LAS u32x4*)(Vs + ss_ * SB_KS + 8 * sc_) = vreg;
        if (jt > 0) { const bf16_t* p = kvp + (size_t)((jt - 1) * 64) * NINP; kreg = *(const u32x4*)(p + 512); vreg = *(const u32x4*)(p + 1024); }
        LBAR();
        { const int f = dflag[(par ^ 1) * 8 + (lane & 7)];
          if (__builtin_amdgcn_readfirstlane(__builtin_popcountll(__ballot(f != 0))) == 64) break; }
        const int k0 = jt * 64;
        if (k0 < q0 + wid * 16 + 15 && __ballot(carry < -160.f) != ~0ull) {
            if (k0 + 63 >= q0 + wid * 16) sb_tile<true>(Ks, Vs, k0, tq, fr, fq, qf, UA, UB, ONES, oacc, carry);
            else sb_tile<false>(Ks, Vs, k0, tq, fr, fq, qf, UA, UB, ONES, oacc, carry);
        }
        { const bool dead = __ballot(carry < -160.f) == ~0ull; if (lane == 0) dflag[par * 8 + wid] = dead ? 1 : 0; }
        cur ^= 1; par ^= 1;
    }
    bf16_t* op = mixo + (rowbase + tq) * D + h * 64 + 4 * fq;
#pragma unroll
    for (int dt = 0; dt < 4; ++dt) { u32x2 w; w.x = pk(oacc[dt][0], oacc[dt][1]); w.y = pk(oacc[dt][2], oacc[dt][3]); *(u32x2*)(op + 16 * dt) = w; }
    LBAR();
}

constexpr int ML_QS = 136, ML_VS = 152, ML_CTS = 136;
constexpr int ML_Q = 0, ML_K = ML_Q + 64 * ML_QS * 2, ML_V = ML_K + 64 * ML_QS * 2, ML_CT = ML_V + 64 * ML_VS * 2,
              ML_VEC = ML_CT + 144 * ML_CTS * 2, ML_EX = ML_VEC + 8 * 64 * 4, ML_CW = ML_EX + 2 * 64 * 4, ML_END = ML_CW + 10 * 128 * 4;
static_assert(ML_END <= RING_BYTES, "mlstm LDS");
constexpr int ML_SLOT = 144 * 128 * 2;
__device__ __forceinline__ unsigned char* ml_slot(float* dout, int item) { return (unsigned char*)dout + (size_t)(item >> 7) * ((size_t)SEQ * D * 4) + (size_t)(item & 127) * ML_SLOT; }
__device__ __forceinline__ bf16_t* ml_kbuf(float* dout, int item) { return (bf16_t*)((unsigned char*)dout + (size_t)(item >> 7) * ((size_t)SEQ * D * 4) + 5 * MiB + (size_t)(item & 127) * (64 * 128 * 2)); }
template <int MODE>
__device__ __forceinline__ void mlstm_item(const Ctx& C, const Args& a, int l, int item) {
    const int tid = C.tid, lane = C.lane, wid = C.wave, fr = lane & 15, fq = lane >> 4;
    const int b = item >> 7, h = (item >> 5) & 3, c = item & 31;
    unsigned char* ws = a.ws;
    const bf16_t* proj = (const bf16_t*)(ws + WS_BIG); bf16_t* mixo = (bf16_t*)(ws + WS_MIXO);
    const float* gi = (const float*)(ws + WS_GI) + (size_t)(b * 4 + h) * SEQ; const float* gf = (const float*)(ws + WS_GF) + (size_t)(b * 4 + h) * SEQ;
    float* mlA = (float*)(ws + WS_MLS); float* mlG = mlA + 1024; float* mlM = mlA + 2048;
    LAS bf16_t* Qs = (LAS bf16_t*)(C.lds + ML_Q); LAS bf16_t* Ks = (LAS bf16_t*)(C.lds + ML_K); LAS bf16_t* Vs = (LAS bf16_t*)(C.lds + ML_V); LAS bf16_t* Ct = (LAS bf16_t*)(C.lds + ML_CT);
    LAS float* vec = (LAS float*)(C.lds + ML_VEC);
    LAS float* ex = (LAS float*)(C.lds + ML_EX); LAS float* cw = (LAS float*)(C.lds + ML_CW);
    const size_t rowbase = (size_t)b * SEQ;
    const int dch = tid & 15, rg = tid >> 4;
    const int vs = tid >> 3, vc = tid & 7;
    const int tt = wid & 3, half = wid >> 2;
    const float q_scale = 0.08838834764831845f;
    const int s0 = c * 64;
    {
        float cwr[3];
        { const float* wc_ = a.in[9] + (size_t)l * 4 * 1024; const float* bc_ = a.in[10] + (size_t)l * 1024;
#pragma unroll
          for (int k = 0; k < 2; ++k) { const int i = tid + 512 * k; const int which = i >> 9, j = (i >> 7) & 3, d = i & 127; cwr[k] = wc_[j * 1024 + which * 512 + h * 128 + d]; }
          { const int which = (tid >> 7) & 1, d = tid & 127; cwr[2] = bc_[which * 512 + h * 128 + d]; } }
        u32x4 cst[5];
        if (MODE == 1) { const u32x4* src = (const u32x4*)ml_slot(a.out, item);
#pragma unroll
            for (int k = 0; k < 5; ++k) { const int i = tid + 512 * k; cst[k] = (i < 144 * 16) ? src[i] : (u32x4){0u, 0u, 0u, 0u}; } }
        u32x4 ur[2][5];
#pragma unroll
        for (int which = (MODE == 0 ? 1 : 0); which < 2; ++which)
#pragma unroll
            for (int i = 0; i < 5; ++i) {
                const int sr = s0 + 2 * rg - 3 + i;
                if (MODE == 1 && which == 1) { ur[1][i] = (i < 2) ? *(const u32x4*)(ml_kbuf(a.out, item) + (2 * rg + i) * 128 + 8 * dch) : (u32x4){0u, 0u, 0u, 0u}; }
                else if (sr >= 0) ur[which][i] = *(const u32x4*)(proj + (rowbase + sr) * NINP + h * 128 + 8 * dch + 1536 + 512 * which);
                else ur[which][i] = (u32x4){0u, 0u, 0u, 0u};
            }
        const bf16_t* vp = proj + (rowbase + s0 + vs) * NINP + 2560 + h * 128 + 16 * vc;
        const u32x4 v0 = *(const u32x4*)vp, v1 = *(const u32x4*)(vp + 8);
        float lf = 0.f, li = 0.f;
        if (wid == 0) { lf = gf[s0 + lane]; li = gi[s0 + lane]; }
        cw[tid] = cwr[0]; cw[tid + 512] = cwr[1]; if (tid < 256) cw[1024 + tid] = cwr[2];
        LBAR();
        if (tid < 128) { unsigned o1 = 0x3F803F80u; asm volatile("" : "+v"(o1));
            const u32x4 one = (u32x4){o1, o1, o1, o1}; *(LAS u32x4*)(Vs + (tid >> 1) * ML_VS + 128 + 8 * (tid & 1)) = one; }
        *(LAS u32x4*)(Vs + vs * ML_VS + 16 * vc) = v0; *(LAS u32x4*)(Vs + vs * ML_VS + 16 * vc + 8) = v1;
        if (MODE == 1) {
#pragma unroll
            for (int k = 0; k < 5; ++k) { const int i = tid + 512 * k; if (i < 144 * 16) { const int e = i >> 4, ch = i & 15; *(LAS u32x4*)(Ct + e * ML_CTS + 8 * ch) = cst[k]; } } }
#pragma unroll
        for (int which = (MODE == 0 ? 1 : 0); which < 2; ++which) {
#pragma unroll
            for (int rr = 0; rr < 2; ++rr) {
                if (MODE == 1 && which == 1) { *(LAS u32x4*)(Ks + (2 * rg + rr) * ML_QS + 8 * dch) = ur[1][rr]; continue; }
                f32x4 ya = *(const LAS f32x4*)(cw + 1024 + which * 128 + 8 * dch), yb = *(const LAS f32x4*)(cw + 1024 + which * 128 + 8 * dch + 4);
#pragma unroll
                for (int j = 0; j < 4; ++j) {
                    const u32x4 u = ur[which][rr + j];
                    ya = ya + (f32x4){bflo(u.x), bfhi(u.x), bflo(u.y), bfhi(u.y)} * *(const LAS f32x4*)(cw + which * 512 + j * 128 + 8 * dch);
                    yb = yb + (f32x4){bflo(u.z), bfhi(u.z), bflo(u.w), bfhi(u.w)} * *(const LAS f32x4*)(cw + which * 512 + j * 128 + 8 * dch + 4);
                }
                float y[8] = {ya.x, ya.y, ya.z, ya.w, yb.x, yb.y, yb.z, yb.w};
#pragma unroll
                for (int i = 0; i < 8; ++i) { y[i] = y[i] * sigmoidf_(y[i]); if (!which) y[i] *= q_scale; }
                const int r = 2 * rg + rr;
                u32x4 w; w.x = pk(y[0], y[1]); w.y = pk(y[2], y[3]); w.z = pk(y[4], y[5]); w.w = pk(y[6], y[7]);
                *(LAS u32x4*)((which ? Ks : Qs) + r * ML_QS + 8 * dch) = w;
                if (MODE == 0) *(u32x4*)(ml_kbuf(a.out, item) + r * 128 + 8 * dch) = w;
            }
        }
        if (wid == 0) {
            float bc = lf;
#pragma unroll
            for (int o = 1; o < 64; o <<= 1) { const float t = __shfl_up(bc, o); if (lane >= o) bc += t; }
            const float ct = li - bc; float pm = ct;
#pragma unroll
            for (int o = 1; o < 64; o <<= 1) { const float t = __shfl_up(pm, o); if (lane >= o) pm = fmaxf(pm, t); }
            const float b63 = __shfl(bc, 63);
            if (MODE == 0) {
                const float a_c = b63 + __shfl(pm, 63);
                vec[256 + lane] = fexp(b63 + ct - a_c);
                if (lane == 0) { mlA[item] = a_c; mlG[item] = b63; }
            } else {
                const float m_st = mlM[item];
                const float mt = bc + fmaxf(pm, m_st);
                vec[lane] = bc; vec[64 + lane] = ct; vec[128 + lane] = mt; vec[192 + lane] = fexp(bc + m_st - mt); vec[320 + lane] = fexp(-mt);
            }
        }
    }
    LBAR();
    if (MODE == 1) {
        const int t = 16 * tt + fr;
        bf16x8 qfr[4];
#pragma unroll
        for (int kk = 0; kk < 4; ++kk) qfr[kk] = *(const LAS bf16x8*)(Qs + t * ML_QS + 32 * kk + 8 * fq);
        const float rowterm = vec[t] - vec[128 + t], winter = vec[192 + t], einv = vec[320 + t];
        unsigned pw[2][4];
#pragma unroll
        for (int i = 0; i < 4; ++i) {
            f32x4 sa = (f32x4){0.f, 0.f, 0.f, 0.f};
#pragma unroll
            for (int kk = 0; kk < 4; ++kk) { const bf16x8 kf = *(const LAS bf16x8*)(Ks + (16 * i + fr) * ML_QS + 32 * kk + 8 * fq); sa = mfma16(kf, qfr[kk], sa); }
            const f32x4 ctv = *(const LAS f32x4*)(vec + 64 + 16 * i + 4 * fq);
            float sc[4];
#pragma unroll
            for (int e = 0; e < 4; ++e) { const int s = 16 * i + 4 * fq + e; sc[e] = (s <= t) ? sa[e] * fexp(rowterm + ctv[e]) : 0.f; }
            pw[i >> 1][(i & 1) * 2 + 0] = pk(sc[0], sc[1]); pw[i >> 1][(i & 1) * 2 + 1] = pk(sc[2], sc[3]);
        }
        const bf16x8 P0 = mk8u(pw[0][0], pw[0][1], pw[0][2], pw[0][3]), P1 = mk8u(pw[1][0], pw[1][1], pw[1][2], pw[1][3]);
        f32x4 num[5];
#pragma unroll
        for (int ei = 0; ei < 5; ++ei) {
            const int et = (ei == 4) ? 8 : 4 * half + ei;
            const LAS bf16_t* vr = Vs + (4 * fq + (fr >> 2)) * ML_VS + 16 * et + 4 * (fr & 3);
            const bf16x8 v0 = mk8(trd(vr), trd(vr + 16 * ML_VS)), v1 = mk8(trd(vr + 32 * ML_VS), trd(vr + 48 * ML_VS));
            f32x4 intra = (f32x4){0.f, 0.f, 0.f, 0.f}; intra = mfma16(v0, P0, intra); intra = mfma16(v1, P1, intra);
            f32x4 inter = (f32x4){0.f, 0.f, 0.f, 0.f};
#pragma unroll
            for (int kk = 0; kk < 4; ++kk) { const bf16x8 cf = *(const LAS bf16x8*)(Ct + (16 * et + fr) * ML_CTS + 32 * kk + 8 * fq); inter = mfma16(cf, qfr[kk], inter); }
            num[ei] = intra + inter * winter;
        }
        const float den = fmaxf(fabsf(num[4][0]), einv); const float dinv = 1.f / den;
        float sq = 0.f;
#pragma unroll
        for (int ei = 0; ei < 4; ++ei) { num[ei] = num[ei] * dinv; sq += (num[ei][0] * num[ei][0] + num[ei][1] * num[ei][1]) + (num[ei][2] * num[ei][2] + num[ei][3] * num[ei][3]); }
        sq += __shfl_xor(sq, 16); sq += __shfl_xor(sq, 32);
        if (fq == 0) ex[half * 64 + t] = sq;
        LBAR();
        const float tot = ex[t] + ex[64 + t]; const float rn = __builtin_amdgcn_rsqf(tot * (1.f / 128.f) + EPS);
        const float* gh = a.in[11] + (size_t)l * 512 + h * 128;
        const bf16_t* og = proj + (rowbase + s0 + t) * NINP + 3072 + h * 128;
        bf16_t* op = mixo + (rowbase + s0 + t) * D + 512 + h * 128;
#pragma unroll
        for (int ei = 0; ei < 4; ++ei) {
            const int e0 = 16 * (4 * half + ei) + 4 * fq;
            const f32x4 g4 = *(const f32x4*)(gh + e0); const u32x2 o2 = *(const u32x2*)(og + e0);
            const float y0 = num[ei][0] * rn * g4.x * sigmoidf_(bflo(o2.x)), y1 = num[ei][1] * rn * g4.y * sigmoidf_(bfhi(o2.x));
            const float y2 = num[ei][2] * rn * g4.z * sigmoidf_(bflo(o2.y)), y3 = num[ei][3] * rn * g4.w * sigmoidf_(bfhi(o2.y));
            u32x2 w; w.x = pk(y0, y1); w.y = pk(y2, y3); *(u32x2*)(op + e0) = w;
        }
    }
    if (MODE == 0) {
        bf16x8 kw[2];
#pragma unroll
        for (int kk = 0; kk < 2; ++kk) {
            const LAS bf16_t* kr = Ks + (32 * kk + 8 * fq + (fr >> 2)) * ML_QS + 16 * wid + 4 * (fr & 3);
            const u32x2 k0 = trd(kr), k1 = trd(kr + 4 * ML_QS);
            const f32x4 w0 = *(const LAS f32x4*)(vec + 256 + 32 * kk + 8 * fq), w1 = *(const LAS f32x4*)(vec + 256 + 32 * kk + 8 * fq + 4);
            kw[kk] = mk8u(pk(bflo(k0.x) * w0.x, bfhi(k0.x) * w0.y), pk(bflo(k0.y) * w0.z, bfhi(k0.y) * w0.w),
                          pk(bflo(k1.x) * w1.x, bfhi(k1.x) * w1.y), pk(bflo(k1.y) * w1.z, bfhi(k1.y) * w1.w));
        }
        bf16_t* slot = (bf16_t*)ml_slot(a.out, item);
#pragma unroll
        for (int et = 0; et < 9; ++et) {
            f32x4 cacc = (f32x4){0.f, 0.f, 0.f, 0.f};
#pragma unroll
            for (int kk = 0; kk < 2; ++kk) {
                const LAS bf16_t* vr = Vs + (32 * kk + 8 * fq + (fr >> 2)) * ML_VS + 16 * et + 4 * (fr & 3);
                const bf16x8 vf = mk8(trd(vr), trd(vr + 4 * ML_VS));
                cacc = mfma16(kw[kk], vf, cacc);
            }
            u32x2 w; w.x = pk(cacc[0], cacc[1]); w.y = pk(cacc[2], cacc[3]);
            *(u32x2*)(slot + (size_t)(16 * et + fr) * 128 + 16 * wid + 4 * fq) = w;
        }
    }
    LBAR();
}

__device__ __forceinline__ void mlstm_scan(const Ctx& C, const Args& a) {
    unsigned char* ws = a.ws;
    const float* mlA = (const float*)(ws + WS_MLS); const float* mlG = mlA + 1024; float* mlM = (float*)(ws + WS_MLS) + 2048;
    const bool gm = a.use_group != 0;
    for (int w = gm ? (C.blk & 7) * 32 + (C.blk >> 3) : C.blk; w < (gm ? ((C.blk & 7) + 1) * 32 : 256); w += (gm ? (C.G >> 3) : C.G)) {
        const int bh = w >> 3, slice = w & 7;
        if (C.tid < 384) {
            const int widx = slice * 1152 + C.tid;
            float st[6] = {0.f, 0.f, 0.f, 0.f, 0.f, 0.f}; float m = 0.f;
            unsigned sw[32][3];
#pragma unroll
            for (int cc = 0; cc < 32; ++cc) { const unsigned* sp = (const unsigned*)ml_slot(a.out, bh * 32 + cc) + widx;
#pragma unroll
                for (int j = 0; j < 3; ++j) sw[cc][j] = sp[384 * j]; }
#pragma unroll
            for (int cc = 0; cc < 32; ++cc) {
                const int item = bh * 32 + cc;
                const float a_c = mlA[item], g_c = mlG[item];
                const float m_new = fmaxf(g_c + m, a_c), al = fexp(g_c + m - m_new), be = fexp(a_c - m_new);
                unsigned* dp = (unsigned*)ml_slot(a.out, item) + widx;
#pragma unroll
                for (int j = 0; j < 3; ++j) {
                    dp[384 * j] = pk(st[2 * j], st[2 * j + 1]);
                    st[2 * j] = al * st[2 * j] + be * bflo(sw[cc][j]); st[2 * j + 1] = al * st[2 * j + 1] + be * bfhi(sw[cc][j]);
                }
                if (slice == 0 && C.tid == 0) mlM[item] = m;
                m = m_new;
            }
        }
    }
}

constexpr int XA_KS = 264;
constexpr int XA_BUF = 64 * XA_KS * 2;
template <bool QL = false>
__device__ __forceinline__ void xattn_unit(const Ctx& C, const bf16_t* qn, const bf16_t* kv, bf16_t* obuf, int l, int b, int h, int qb, const LAS bf16_t* qlds = nullptr, int kvoff = 0) {
    const int tid = C.tid, lane = C.lane, wid = C.wave, fr = lane & 15, fq = lane >> 4;
    const int t = qb * 128 + wid * 16 + fr;
    const size_t qrow = (size_t)b * SEQ + t;
    bf16x8 qf[8];
    if (QL) { const LAS bf16_t* qp = qlds + (wid * 16 + fr) * XA_KS + 8 * fq;
#pragma unroll
      for (int kk = 0; kk < 8; ++kk) qf[kk] = *(const LAS bf16x8*)(qp + 32 * kk); }
    else { const bf16_t* qp = qn + qrow * D + (size_t)b * (GX_Q / 2) + h * 256 + 8 * fq;
#pragma unroll
      for (int kk = 0; kk < 8; ++kk) qf[kk] = *(const bf16x8*)(qp + 32 * kk); }
    const int ss_ = tid >> 3, sc_ = tid & 7;
    const bf16_t* kbase = kv + ((size_t)b * MEML + ss_) * 4096 + l * 2048 + h * 256 + 8 * sc_;
#define XA_SRC(s_) (((s_) < 4) ? kbase + (size_t)(64 * (s_)) * 4096 : kbase + 1024 + (size_t)(64 * ((s_) - 4)) * 4096)
    u32x4 st[2][4];
#pragma unroll
    for (int i = 0; i < 4; ++i) { st[0][i] = *(const u32x4*)(XA_SRC(0) + 64 * i); st[1][i] = *(const u32x4*)(XA_SRC(1) + 64 * i); }
    f32x4 S[16];
    int cur = 0;
#pragma unroll
    for (int c = 0; c < 4; ++c) {
        LAS bf16_t* Kc = (LAS bf16_t*)(C.lds + kvoff + cur * XA_BUF);
#pragma unroll
        for (int i = 0; i < 4; ++i) *(LAS u32x4*)(Kc + ss_ * XA_KS + 8 * sc_ + 64 * i) = st[c & 1][i];
        { const bf16_t* nb = XA_SRC(c + 2);
#pragma unroll
          for (int i = 0; i < 4; ++i) st[c & 1][i] = *(const u32x4*)(nb + 64 * i); }
        LBAR();
#pragma unroll
        for (int i = 0; i < 4; ++i) {
            f32x4 sa = (f32x4){0.f, 0.f, 0.f, 0.f};
#pragma unroll
            for (int kk = 0; kk < 8; ++kk) { const bf16x8 kf = *(const LAS bf16x8*)(Kc + (16 * i + fr) * XA_KS + 32 * kk + 8 * fq); sa = mfma16(kf, qf[kk], sa); }
            S[4 * c + i] = sa;
        }
        cur ^= 1;
    }
    float mx = -1e30f;
#pragma unroll
    for (int i = 0; i < 16; ++i) mx = fmaxf(mx, fmaxf(fmaxf(S[i][0], S[i][1]), fmaxf(S[i][2], S[i][3])));
    mx = fmaxf(mx, __shfl_xor(mx, 16)); mx = fmaxf(mx, __shfl_xor(mx, 32));
    float sum = 0.f;
#pragma unroll
    for (int i = 0; i < 16; ++i)
#pragma unroll
        for (int e = 0; e < 4; ++e) { const float p = fexp((S[i][e] - mx) * 0.0625f); S[i][e] = p; sum += p; }
    sum += __shfl_xor(sum, 16); sum += __shfl_xor(sum, 32);
    bf16x8 pf[8];
#pragma unroll
    for (int k2 = 0; k2 < 8; ++k2) pf[k2] = mk8u(pk(S[2 * k2][0], S[2 * k2][1]), pk(S[2 * k2][2], S[2 * k2][3]), pk(S[2 * k2 + 1][0], S[2 * k2 + 1][1]), pk(S[2 * k2 + 1][2], S[2 * k2 + 1][3]));
    f32x4 O[16];
#pragma unroll
    for (int i = 0; i < 16; ++i) O[i] = (f32x4){0.f, 0.f, 0.f, 0.f};
#pragma unroll
    for (int c = 0; c < 4; ++c) {
        LAS bf16_t* Vc = (LAS bf16_t*)(C.lds + kvoff + cur * XA_BUF);
#pragma unroll
        for (int i = 0; i < 4; ++i) *(LAS u32x4*)(Vc + ss_ * XA_KS + 8 * sc_ + 64 * i) = st[c & 1][i];
        if (c < 2) { const bf16_t* nb = XA_SRC(c + 6);
#pragma unroll
            for (int i = 0; i < 4; ++i) st[c & 1][i] = *(const u32x4*)(nb + 64 * i); }
        LBAR();
#pragma unroll
        for (int dt = 0; dt < 16; ++dt) {
            const LAS bf16_t* vr = Vc + (4 * fq + (fr >> 2)) * XA_KS + 16 * dt + 4 * (fr & 3);
            const bf16x8 v0 = mk8(trd(vr), trd(vr + 16 * XA_KS)), v1 = mk8(trd(vr + 32 * XA_KS), trd(vr + 48 * XA_KS));
            O[dt] = mfma16(v0, pf[2 * c], O[dt]); O[dt] = mfma16(v1, pf[2 * c + 1], O[dt]);
        }
        cur ^= 1;
    }
    const float inv = 1.f / sum;
    bf16_t* op = obuf + qrow * D + (size_t)b * (GX_Q / 2) + h * 256 + 4 * fq;
#pragma unroll
    for (int dt = 0; dt < 16; ++dt) { u32x2 w; w.x = pk(O[dt][0] * inv, O[dt][1] * inv); w.y = pk(O[dt][2] * inv, O[dt][3] * inv); *(u32x2*)(op + 16 * dt) = w; }
    LBAR();
}

struct EpiQXattn {
    static constexpr bool USE_RT = true, AFTER_DRAIN = true;
    const float* ss; const float* gain; LAS float* P; LAS unsigned char* lds; const bf16_t* kv; bf16_t* obuf; int l;
    __device__ __forceinline__ void operator()(const pg8::Acc& acc, const pg8::Unit& u, int wr, int wc, int fr, int fq, const pg8::RowTab& T) const {
        using namespace pg8;
        float rn[2][4];
#pragma unroll
        for (int ai = 0; ai < 2; ++ai)
#pragma unroll
            for (int m = 0; m < 4; ++m) {
                const float r = rs_get(T, ss, u, ai * HALF + wr * 64 + m * 16 + fr); rn[ai][m] = r; float sq = 0.f;
#pragma unroll
                for (int bj = 0; bj < 2; ++bj)
#pragma unroll
                    for (int n = 0; n < 2; ++n) { const f32x4 v = acc[ai][bj][m][n] * r; sq += (v.x * v.x + v.y * v.y) + (v.z * v.z + v.w * v.w); }
                sq += __shfl_xor(sq, 16); sq += __shfl_xor(sq, 32);
                if (fq == 0) P[(ai * HALF + wr * 64 + m * 16 + fr) * 4 + wc] = sq;
            }
        LBAR();
        f32x4 g[2][2];
#pragma unroll
        for (int bj = 0; bj < 2; ++bj)
#pragma unroll
            for (int n = 0; n < 2; ++n) g[bj][n] = *(const f32x4*)(gain + bj * HALF + wc * 32 + 8 * fq + 4 * n);
#pragma unroll
        for (int ai = 0; ai < 2; ++ai)
#pragma unroll
            for (int m = 0; m < 4; ++m) { const f32x4 p = *(const LAS f32x4*)(P + (ai * HALF + wr * 64 + m * 16 + fr) * 4);
                rn[ai][m] *= __builtin_amdgcn_rsqf(((p.x + p.y) + (p.z + p.w)) * (1.f / 256.f) + EPS); }
        Ctx C2; { int t_ = threadIdx.x; asm volatile("" : "+v"(t_)); C2.tid = t_; C2.lane = t_ & 63; C2.wave = __builtin_amdgcn_readfirstlane(t_ >> 6); } C2.lds = lds; C2.G = gridDim.x; C2.blk = blockIdx.x;
        LAS bf16_t* Qs = (LAS bf16_t*)lds;
        const int b = u.pm >> 3, h = u.pn;
        u32x4 qw[2][4][2];
#pragma unroll
        for (int hf = 0; hf < 2; ++hf)
#pragma unroll
            for (int m = 0; m < 4; ++m)
#pragma unroll
                for (int bj = 0; bj < 2; ++bj) {
                    const f32x4 a = acc[hf][bj][m][0] * rn[hf][m] * g[bj][0], c = acc[hf][bj][m][1] * rn[hf][m] * g[bj][1];
                    u32x4 w; w.x = pk(a.x, a.y); w.y = pk(a.z, a.w); w.z = pk(c.x, c.y); w.w = pk(c.z, c.w); qw[hf][m][bj] = w;
                }
#pragma unroll
        for (int hf = 0; hf < 2; ++hf) {
            LBAR();
#pragma unroll
            for (int m = 0; m < 4; ++m)
#pragma unroll
                for (int bj = 0; bj < 2; ++bj) *(LAS u32x4*)(Qs + (wr * 64 + m * 16 + fr) * XA_KS + bj * HALF + wc * 32 + 8 * fq) = qw[hf][m][bj];
            LBAR();
            xattn_unit<true>(C2, nullptr, kv, obuf, l, b, h, (u.pm & 7) * 2 + hf, Qs, 128 * XA_KS * 2);
        }
    }
};
static_assert(128 * XA_KS * 2 + 2 * XA_BUF <= MISC_OFF, "query tile + K/V chunk buffers below the LDS control words");

#define XB_TMO      128
#define XB_XCNT(j)  (256  + 64 * (j))
#define XB_XSUB(j)  (1280 + 64 * (j))
#define XB_XGEN(j)  (2304 + 64 * (j))
#define XB_TOP      3328
#define XB_TOPGEN   3392
#define XCD_BAR_WORDS 3456
#define XB_SPIN_CAP (1u << 22)
constexpr int CW_BAR = 4096;
constexpr size_t CTL_ZERO_BYTES = 64 * 1024;
__device__ __forceinline__ unsigned xb_ld(unsigned* p)              { return __hip_atomic_load(p, __ATOMIC_RELAXED, __HIP_MEMORY_SCOPE_AGENT); }
__device__ __forceinline__ unsigned xb_add(unsigned* p, unsigned v) { return __hip_atomic_fetch_add(p, v, __ATOMIC_RELAXED, __HIP_MEMORY_SCOPE_AGENT); }
__device__ __forceinline__ unsigned xb_xcc_id() { return (unsigned)__builtin_amdgcn_s_getreg((3 << 11) | 20) & 0xFu; }
#define XB_SPIN(cond, bar) do { unsigned _sp = 0; while (cond) { __builtin_amdgcn_s_sleep(1); \
    if ((++_sp & 255u) == 0u) { if (xb_ld(&(bar)[XB_TMO])) break; if (_sp > XB_SPIN_CAP) { atomicAdd(&(bar)[XB_TMO], 1u); break; } } } } while (0)
struct XcdBarrier { unsigned* bar; unsigned x; volatile LAS unsigned* st; };
__device__ __forceinline__ XcdBarrier xcd_barrier_post(unsigned* bar, volatile LAS unsigned* st) {
    XcdBarrier b; b.bar = bar; b.x = xb_xcc_id(); b.st = st;
    if (threadIdx.x == 0) (void)xb_add(&bar[XB_XCNT(b.x)], 1u);
    return b;
}
__device__ __forceinline__ void xcd_barrier_complete(unsigned* bar, unsigned x, unsigned& nloc, unsigned& nx) {
    const unsigned G = gridDim.x * gridDim.y * gridDim.z;
    unsigned sum, cnt, mine, sp = 0u;
    for (;;) {
        sum = 0u; cnt = 0u; mine = 0u;
#pragma unroll
        for (unsigned j = 0; j < 16; ++j) { const unsigned c = xb_ld(&bar[XB_XCNT(j)]); sum += c; cnt += (c > 0u) ? 1u : 0u; mine = (j == x) ? c : mine; }
        if (sum == G) break;
        __builtin_amdgcn_s_sleep(1);
        if ((++sp & 255u) == 0u) { if (xb_ld(&bar[XB_TMO])) break; if (sp > XB_SPIN_CAP) { atomicAdd(&bar[XB_TMO], 1u); break; } }
    }
    nloc = mine > 0u ? mine : 1u; nx = cnt > 0u ? cnt : 1u;
}
__device__ __forceinline__ void xcd_barrier(const XcdBarrier& b) {
    asm volatile("s_waitcnt vmcnt(0)" ::: "memory");
    __syncthreads();
    if (threadIdx.x == 0) {
        unsigned* bar = b.bar;
        __builtin_amdgcn_s_waitcnt(0);
        unsigned nloc = b.st[0], nx = b.st[1];
        if (nloc == 0u) { xcd_barrier_complete(bar, b.x, nloc, nx); b.st[0] = nloc; b.st[1] = nx; }
        const unsigned old = xb_add(&bar[XB_XSUB(b.x)], 1u);
        const unsigned gen = old / nloc;
        if (old + 1u == (gen + 1u) * nloc) {
            __builtin_amdgcn_fence(__ATOMIC_RELEASE, "agent");
            asm volatile("s_waitcnt vmcnt(0)" ::: "memory");
            const unsigned og = xb_add(&bar[XB_TOP], 1u);
            const unsigned tg = og / nx;
            if (og + 1u == (tg + 1u) * nx) xb_add(&bar[XB_TOPGEN], 1u);
            else XB_SPIN(xb_ld(&bar[XB_TOPGEN]) == tg, bar);
            __builtin_amdgcn_fence(__ATOMIC_ACQUIRE, "agent");
            xb_add(&bar[XB_XGEN(b.x)], 1u);
            asm volatile("s_waitcnt vmcnt(0)" ::: "memory");
        } else {
            XB_SPIN(xb_ld(&bar[XB_XGEN(b.x)]) == gen, bar);
            __builtin_amdgcn_fence(__ATOMIC_ACQUIRE, "agent");
            asm volatile("s_waitcnt vmcnt(0)" ::: "memory");
        }
    }
    __syncthreads();
}

constexpr int CW_GRP = 8192, CW_GMASK = 12288;
template <bool HEAVY>
__device__ __forceinline__ void group_barrier(unsigned* gctr, unsigned target) {
    asm volatile("s_waitcnt vmcnt(0)" ::: "memory");
    __syncthreads();
    if (threadIdx.x == 0) {
        if (HEAVY) { __builtin_amdgcn_fence(__ATOMIC_RELEASE, "agent"); asm volatile("s_waitcnt vmcnt(0)" ::: "memory"); }
        (void)xb_add(gctr, 1u);
        unsigned sp = 0u;
        while (xb_ld(gctr) < target) { __builtin_amdgcn_s_sleep(1); if (++sp > XB_SPIN_CAP) break; }
        __builtin_amdgcn_fence(__ATOMIC_ACQUIRE, "agent");
        asm volatile("s_waitcnt vmcnt(0)" ::: "memory");
    }
    __syncthreads();
}

__global__ void __launch_bounds__(512, 2) fwd_kernel(Args a) {
    extern __shared__ __attribute__((aligned(16))) unsigned char lds_raw[];
    Ctx C; C.lds = (LAS unsigned char*)lds_raw; C.G = gridDim.x; C.blk = blockIdx.x;
    unsigned char* ws = a.ws;
    const int lo = a.ph_lo, hi = a.ph_hi;
#define xb ((bf16_t*)(a.ws + WS_XB))
#define big ((bf16_t*)(a.ws + WS_BIG))
#define mixo ((bf16_t*)(a.ws + WS_MIXO))
#define qn big
#define ob (big + (size_t)(4 * MiB / 2))
#define ssb0 ((float*)(a.ws + WS_SS))
#define ssb1 (ssb0 + (size_t)M * 4)
    LAS float* P = (LAS float*)(C.lds + XSCR_OFF);
    volatile LAS int* misc = (volatile LAS int*)(C.lds + MISC_OFF);
    XcdBarrier xbar; xbar.bar = nullptr; xbar.x = 0; xbar.st = nullptr;
    if (hi - lo > 1) {
        if (threadIdx.x < 2) misc[8 + threadIdx.x] = 0;
        __syncthreads();
        xbar = xcd_barrier_post((unsigned*)(ws + WS_CTL) + CW_BAR, (volatile LAS unsigned*)(misc + 8));
    }
#ifndef PROBE_DUP_LO
#define PROBE_DUP_LO 0
#define PROBE_DUP_N 0
#endif
    unsigned gk = 0u; const unsigned gmembers = (unsigned)((C.G - (C.blk & 7) + 7) / 8);
    int glocal = -1;
    if (a.use_group && hi - lo > 1 && threadIdx.x == 0) __hip_atomic_fetch_or((unsigned*)(ws + WS_CTL) + CW_GMASK + (C.blk & 7), 1u << xb_xcc_id(), __ATOMIC_RELAXED, __HIP_MEMORY_SCOPE_AGENT);
    for (int it = lo; it < hi; ++it) {
        const int rep = (PROBE_DUP_N > 0 && it >= PROBE_DUP_LO + PROBE_DUP_N && it < PROBE_DUP_LO + 2 * PROBE_DUP_N) ? 1 : 0;
        const int ph = (PROBE_DUP_N > 0 && it >= PROBE_DUP_LO + PROBE_DUP_N) ? it - PROBE_DUP_N : it;
        const int l = ph / 13, p = ph % 13;
#define RELAUNDER() do { int t_ = threadIdx.x; asm volatile("" : "+v"(t_)); C.tid = t_; C.lane = t_ & 63; C.wave = __builtin_amdgcn_readfirstlane(t_ >> 6); } while (0)
        RELAUNDER();
        if (p == 0) conv_phase(C, a, l);
        else if (p == 1 || p == 11) {
            pg8::Gemm g{xb, (const bf16_t*)(ws + (p == 1 ? W_GU1 : W_GU2)), M, NGU, D}; pg8::StaticOrder S; S.init(M, NGU, C.G, C.blk);
            pg8::EpiSwiglu E{big, p == 1 ? ssb0 : ssb1};
            pg8::gemm_phase(C.lds, g, S, E);
            if (ph == 1 && rep == 0) {
                pg8::Gemm g2{(const bf16_t*)(ws + WS_MEMB), (const bf16_t*)(ws + WS_WKV), MM, 4096, D}; pg8::StaticOrder S2; S2.init(MM, 4096, C.G, a.use_group ? C.blk : (C.blk + C.G / 2) % C.G); if (a.use_group) S2.direct_hb = C.G / 2;
                pg8::EpiHeadNorm E2{(bf16_t*)(ws + WS_KV), 4096, (const float*)(ws + WS_SSM), a.in[19], a.in[19] + 256, P, 0};
                pg8::gemm_phase(C.lds, g2, S2, E2);
            }
        } else if (p == 2 || p == 12) {
            pg8::Gemm g{big, (const bf16_t*)(ws + (p == 2 ? W_D1 : W_D2)), M, D, FF, GX_H}; pg8::StaticOrder S; S.init(M, D, C.G, C.blk);
            if (ph == 2) { pg8::EpiResid<true, false> E{a.in[0], a.out, xb, ssb1, 0.5f, P}; pg8::gemm_phase(C.lds, g, S, E); }
            else if (ph == NPH - 1) { pg8::EpiResid<false, true> E{a.in[0], a.out, xb, ssb0, 0.5f, P}; pg8::gemm_phase(C.lds, g, S, E); }
            else { pg8::EpiResid<false, false> E{a.in[0], a.out, xb, p == 2 ? ssb1 : ssb0, 0.5f, P}; pg8::gemm_phase(C.lds, g, S, E); }
        } else if (p == 3) {
            pg8::Gemm g{xb, (const bf16_t*)(ws + W_IN), M, NINP, D}; pg8::StaticOrder S; S.init(M, NINP, C.G, C.blk);
            pg8::EpiProj E{big, NINP, ssb1};
            pg8::gemm_phase(C.lds, g, S, E);
            RELAUNDER();
            gates_pass(C, a, l, ssb1);
        } else if (p == 4 || p == 6) {
            const bool gm = a.use_group != 0; const int gq = C.blk & 7;
            unsigned* ctr = gm ? (unsigned*)(ws + WS_CTL) + 13312 + 64 * (((2 * l + (p == 6 ? 1 : 0)) * 8) + gq) : (unsigned*)(ws + WS_CTL) + 64 * (2 * l + (p == 6 ? 1 : 0) + 4 * rep);
            const int n_ml = gm ? 128 : 1024, n_all = gm ? 192 : 1536;
            if (C.tid == 0) misc[0] = (int)atomicAdd(ctr, 1u);
            LBAR();
            int idx = misc[0];
            LBAR();
            while (idx < n_all) {
                unsigned nxt = 0u;
                if (C.tid == 0) nxt = atomicAdd(ctr, 1u);
                if (idx < n_ml) { const int item = gm ? gq * 128 + idx : idx; if (p == 4) mlstm_item<0>(C, a, l, item); else mlstm_item<1>(C, a, l, item); }
                else if (gm) { const int u2 = 2 * (idx - 128) + (p == 6 ? 1 : 0); sb_unit(C, big, mixo, gq, u2 & 7, 15 - (u2 >> 3)); }
                else { const int u2 = 2 * (idx - 1024) + (p == 6 ? 1 : 0); const int qb = 15 - (u2 >> 6), bh = u2 & 63; sb_unit(C, big, mixo, bh >> 3, bh & 7, qb); }
                if (C.tid == 0) misc[0] = (int)nxt;
                LBAR();
                idx = misc[0];
                LBAR();
            }
        } else if (p == 5) {
            mlstm_scan(C, a);
        } else if (p == 7) {
            pg8::Gemm g{mixo, (const bf16_t*)(ws + W_OUT), M, D, D}; pg8::StaticOrder S; S.init(M, D, C.G, C.blk);
            pg8::EpiResid<false, false> E{a.in[0], a.out, xb, ssb0, 1.0f, P};
            pg8::gemm_phase(C.lds, g, S, E);
        } else if (p == 8) {
            pg8::Gemm g{xb, (const bf16_t*)(ws + W_XQ), M, D, D}; pg8::StaticOrder S; S.init(M, D, C.G, C.blk);
            if ((M / 256) * (D / 256) == C.G) {
                EpiQXattn EQ{ssb0, a.in[18] + l * 256, P, C.lds, (const bf16_t*)(ws + WS_KV), ob, l};
                pg8::gemm_phase(C.lds, g, S, EQ);
            } else {
            pg8::EpiHeadNorm E{qn, D, ssb0, a.in[18] + l * 256, a.in[18] + l * 256, P, GX_Q / 2};
            pg8::gemm_phase(C.lds, g, S, E);
            asm volatile("s_waitcnt vmcnt(0)" ::: "memory"); __syncthreads();
            RELAUNDER();
            { pg8::Unit u; for (int i = 0; S.next(i, u); ++i) { const int b = u.pm >> 3, qb0 = (u.pm & 7) * 2;
                xattn_unit(C, qn, (const bf16_t*)(ws + WS_KV), ob, l, b, u.pn, qb0); xattn_unit(C, qn, (const bf16_t*)(ws + WS_KV), ob, l, b, u.pn, qb0 + 1); } }
            }
        } else if (p == 9) {
        } else if (p == 10) {
            pg8::Gemm g{ob, (const bf16_t*)(ws + W_XO), M, D, D, GX_Q}; pg8::StaticOrder S; S.init(M, D, C.G, C.blk);
            pg8::EpiResid<false, false> E{a.in[0], a.out, xb, ssb1, 1.0f, P};
            pg8::gemm_phase(C.lds, g, S, E);
        }
        if (it + 1 < hi && p != 9) {
            if (lo < 0) cg::this_grid().sync();
            const bool grp = a.use_group && p >= 1 && p <= 11;
            if (grp) {
                if (glocal < 0) glocal = (__builtin_popcount(xb_ld((unsigned*)(ws + WS_CTL) + CW_GMASK + (C.blk & 7))) == 1) ? 1 : 0;
                ++gk; unsigned* gctr = (unsigned*)(ws + WS_CTL) + CW_GRP + 64 * (C.blk & 7);
                if (glocal) group_barrier<false>(gctr, gk * gmembers); else group_barrier<true>(gctr, gk * gmembers);
            } else xcd_barrier(xbar);
        }
    }
}

#undef xb
#undef big
#undef mixo
#undef qn
#undef ob
#undef ssb0
#undef ssb1
extern "C" void kernel_launch(void* const* d_in, const int* in_sizes, int n_in, void* d_out, int out_size, void* d_ws, size_t ws_size, hipStream_t stream) {
    static int grid = 0;
    if (grid == 0) {
        if (n_in != 25 || out_size != M * D || ws_size < WS_END) { fprintf(stderr, "kernel_launch: unexpected problem (n_in %d out %d ws %zu)\n", n_in, out_size, ws_size); grid = -1; return; }
        int dev = 0, cus = 0, per_cu = 0;
        hipGetDevice(&dev); hipDeviceGetAttribute(&cus, hipDeviceAttributeMultiprocessorCount, dev);
        hipFuncSetAttribute((const void*)fwd_kernel, hipFuncAttributeMaxDynamicSharedMemorySize, LDS_BYTES);
        hipOccupancyMaxActiveBlocksPerMultiprocessor(&per_cu, (const void*)fwd_kernel, 512, LDS_BYTES);
        if (per_cu < 1) per_cu = 1;
        grid = cus * per_cu;
        (void)hipGetLastError();
        { const int shp[4][2] = {{M, NGU}, {M, NINP}, {M, D}, {MM, 4096}}; bool ok = true;
          for (int s = 0; s < 4 && ok; ++s) for (int c = 0; c < grid && ok; ++c) { pg8::StaticOrder S; S.init(shp[s][0], shp[s][1], grid, c); pg8::Unit u; int base = -1;
              for (int i = 0; S.next(i, u); ++i) { if (base < 0) base = (u.pm >> 3) << 3; if (u.pm < base || u.pm >= base + 8) ok = false; } }
          if (!ok) { fprintf(stderr, "kernel_launch: unit order does not keep a workgroup inside one 8-panel group on a %d-workgroup grid; nothing launched\n", grid); grid = -1; return; } }
    }
    if (grid < 0) return;
    if (hipMemsetAsync((char*)d_ws + WS_CTL, 0, CTL_ZERO_BYTES, stream) != hipSuccess) { fprintf(stderr, "kernel_launch: memset failed\n"); return; }
    static int use_group = -1;
    if (use_group < 0) {
        bool ok = (grid == 256);
        const int shp2[3] = {NGU, NINP, D};
        for (int s2 = 0; s2 < 3 && ok; ++s2) for (int c = 0; c < grid && ok; ++c) { pg8::StaticOrder S; S.init(M, shp2[s2], grid, c); pg8::Unit u;
            for (int i = 0; S.next(i, u); ++i) if ((u.pm >> 3) != (c & 7)) ok = false; }
        use_group = ok ? 1 : 0;
    }
    Args a{};
    a.use_group = use_group;
    for (int i = 0; i < 25; ++i) a.in[i] = (const float*)d_in[i];
    a.out = (float*)d_out; a.ws = (unsigned char*)d_ws;
#if MK_ONE
    a.ph_lo = 0; a.ph_hi = NPH + PROBE_DUP_N;
    void* args[] = {&a};
    hipError_t e = hipLaunchCooperativeKernel((const void*)fwd_kernel, dim3(grid), dim3(512), args, LDS_BYTES, stream);
    if (e != hipSuccess) fprintf(stderr, "cooperative launch failed: %s (grid %d)\n", hipGetErrorString(e), grid);
#else
#ifndef PH_LIMIT
#define PH_LIMIT NPH
#endif
    for (int ph = 0; ph < PH_LIMIT; ++ph) { a.ph_lo = ph; a.ph_hi = ph + 1; hipLaunchKernelGGL(fwd_kernel, dim3(grid), dim3(512), LDS_BYTES, stream, a); }
#endif
}
```
